# Optimizing an MI355X kernel written in HIP

```python
import jax
import jax.numpy as jnp
from jax import lax
import numpy as np

D_MODEL = 2048
BATCH = 4
SEQ = 4096
DEPTH = 1

N_Q_HEADS = 32
N_KV_HEADS = 4
HEAD_DIM = 64
Q_WIDTH = N_Q_HEADS * HEAD_DIM
KV_WIDTH = N_KV_HEADS * HEAD_DIM
WINDOW = 128
LRU_WIDTH = D_MODEL
LRU_BLOCKS = 8
LRU_BLOCK_WIDTH = LRU_WIDTH // LRU_BLOCKS
CONV_WIDTH = 4
LRU_C = 8.0
IN_SPLITS = (Q_WIDTH, KV_WIDTH, KV_WIDTH, LRU_WIDTH, LRU_WIDTH, D_MODEL, D_MODEL)
IN_WIDTH = sum(IN_SPLITS)
IN_CUTS = [sum(IN_SPLITS[:i + 1]) for i in range(len(IN_SPLITS) - 1)]
N_EXPERTS = 32
TOP_K = 4
D_EXPERT = D_MODEL
SWIGLU_LIMIT = 7.0
SWIGLU_ALPHA = 1.702
EXPERT_BLOCK = 256
PLE_DIM = 256
RMS_EPS = 1e-6

kernel_name = 'hybrid_swa_sink_rglru_moe_block'


def rmsnorm(x, g):
    xf = x.astype(jnp.float32)
    var = jnp.mean(xf * xf, axis=-1, keepdims=True)
    return (xf * lax.rsqrt(var + RMS_EPS)).astype(x.dtype) * g


def sliding_window_attention(q, k, v, sinks):
    b, s, _ = q.shape
    nb = s // WINDOW
    g = N_Q_HEADS // N_KV_HEADS
    qb = q.reshape(b, nb, WINDOW, N_KV_HEADS, g, HEAD_DIM)

    def band(t):
        tb = t.reshape(b, nb, WINDOW, N_KV_HEADS, HEAD_DIM)
        prev = jnp.pad(tb[:, :-1], ((0, 0), (1, 0), (0, 0), (0, 0), (0, 0)))
        return jnp.concatenate([prev, tb], axis=2)

    kk, vv = band(k), band(v)
    scores = jnp.einsum('bnqkgd,bnjkd->bnkgqj', qb, kk).astype(jnp.float32) * (HEAD_DIM ** -0.5)
    i = jnp.arange(WINDOW)[:, None]
    j = jnp.arange(2 * WINDOW)[None, :]
    in_band = (j > i) & (j <= i + WINDOW)
    has_prev = (jnp.arange(nb) > 0)[:, None, None] | (j >= WINDOW)[None]
    mask = in_band[None] & has_prev
    scores = jnp.where(mask[None, :, None, None], scores, jnp.finfo(jnp.float32).min)
    sink = jnp.broadcast_to(sinks.astype(jnp.float32).reshape(1, 1, N_KV_HEADS, g, 1, 1),
                            scores.shape[:-1] + (1,))
    probs = jax.nn.softmax(jnp.concatenate([scores, sink], axis=-1), axis=-1)[..., :-1]
    out = jnp.einsum('bnkgqj,bnjkd->bnqkgd', probs.astype(v.dtype), vv)
    return out.reshape(b, s, Q_WIDTH)


def rglru_branch(u, gate, conv_w, conv_b, w_rg_a, b_rg_a, w_rg_x, b_rg_x, lam):
    b, s, w = u.shape
    upad = jnp.pad(u, ((0, 0), (CONV_WIDTH - 1, 0), (0, 0)))
    uc = conv_b + upad[:, 0:s] * conv_w[0]
    for tap in range(1, CONV_WIDTH):
        uc = uc + upad[:, tap:tap + s] * conv_w[tap]
    ub = uc.reshape(b, s, LRU_BLOCKS, LRU_BLOCK_WIDTH)
    r = jax.nn.sigmoid(jnp.einsum('bsnc,ncd->bsnd', ub, w_rg_a) + b_rg_a).reshape(b, s, w)
    ig = jax.nn.sigmoid(jnp.einsum('bsnc,ncd->bsnd', ub, w_rg_x) + b_rg_x).reshape(b, s, w)
    log_a = (-LRU_C * r.astype(jnp.float32)) * jax.nn.softplus(-lam.astype(jnp.float32))
    a = jnp.exp(log_a)
    mult = jnp.sqrt(-jnp.expm1(2.0 * log_a))
    mult = jnp.where((jnp.arange(s) == 0)[None, :, None], 1.0, mult)
    xin = mult * (ig * uc).astype(jnp.float32)

    def combine(left, right):
        a_l, b_l = left
        a_r, b_r = right
        return a_l * a_r, a_r * b_l + b_r

    _, h = lax.associative_scan(combine, (a, xin), axis=1)
    return h.astype(u.dtype) * jax.nn.gelu(gate)


def moe(xn, w_router, b_router, w1, b1, w2, b2):
    b, s, d = xn.shape
    n = b * s
    xt = xn.reshape(n, d)
    logits = (xt @ w_router + b_router).astype(jnp.float32)
    top_val, top_idx = lax.top_k(logits, TOP_K)
    top_w = jax.nn.softmax(top_val, axis=-1).astype(xn.dtype)
    nk = n * TOP_K
    e_flat = top_idx.reshape(nk).astype(jnp.int32)
    tok_flat = jnp.arange(nk, dtype=jnp.int32) // TOP_K
    w_flat = top_w.reshape(nk)
    order = jnp.argsort(e_flat)
    e_sorted = e_flat[order]
    counts = jnp.bincount(e_flat, length=N_EXPERTS).astype(jnp.int32)
    padded = (counts + EXPERT_BLOCK - 1) // EXPERT_BLOCK * EXPERT_BLOCK
    start = jnp.cumsum(counts) - counts
    pend = jnp.cumsum(padded)
    pstart = pend - padded
    dest = pstart[e_sorted] + jnp.arange(nk, dtype=jnp.int32) - start[e_sorted]
    n_rows = (-(-nk // EXPERT_BLOCK) + N_EXPERTS) * EXPERT_BLOCK
    row_tok = jnp.full((n_rows,), n, jnp.int32).at[dest].set(tok_flat[order])
    row_w = jnp.zeros((n_rows,), xn.dtype).at[dest].set(w_flat[order])
    n_blk = n_rows // EXPERT_BLOCK
    blk_start = jnp.arange(n_blk, dtype=jnp.int32) * EXPERT_BLOCK
    blk_expert = jnp.minimum(jnp.searchsorted(pend, blk_start, side='right'), N_EXPERTS - 1)
    x_rows = jnp.concatenate([xt, jnp.zeros((1, d), xt.dtype)], axis=0)[row_tok]
    x_rows = x_rows.reshape(n_blk, EXPERT_BLOCK, d)

    def expert_block(args):
        xb, e = args
        hmid = xb @ w1[e] + b1[e]
        glu, lin = jnp.split(hmid, 2, axis=-1)
        glu = jnp.minimum(glu, SWIGLU_LIMIT)
        lin = jnp.clip(lin, -SWIGLU_LIMIT, SWIGLU_LIMIT)
        act = glu * jax.nn.sigmoid(SWIGLU_ALPHA * glu) * (lin + 1.0)
        return act @ w2[e] + b2[e]

    y_rows = lax.map(expert_block, (x_rows, blk_expert)).reshape(n_rows, d)
    y = jax.ops.segment_sum(y_rows * row_w[:, None], row_tok, num_segments=n + 1)[:n]
    return y.reshape(b, s, d)


def setup_inputs(seed: int = 0) -> dict:
    key = jax.random.key(seed)
    ks = jax.random.split(key, 32)
    L, D = DEPTH, D_MODEL

    def nrm(k, shape, scale):
        return jax.random.normal(k, shape, jnp.float32) * scale

    a_c = jax.random.uniform(ks[10], (L, LRU_WIDTH), jnp.float32, 0.9, 0.999)
    s_base = a_c ** (1.0 / LRU_C)
    lam = jnp.log(s_base) - jnp.log1p(-s_base)
    return {
        'x': nrm(ks[0], (BATCH, SEQ, D), 1.0),
        'p': nrm(ks[1], (L, BATCH, SEQ, PLE_DIM), 1.0),
        'norm_mix_g': 1.0 + nrm(ks[2], (L, D), 0.01),
        'w_in': nrm(ks[3], (L, D, IN_WIDTH), D ** -0.5),
        'b_in': nrm(ks[4], (L, IN_WIDTH), 0.01),
        'conv_w': nrm(ks[5], (L, CONV_WIDTH, LRU_WIDTH), CONV_WIDTH ** -0.5),
        'conv_b': nrm(ks[6], (L, LRU_WIDTH), 0.01),
        'w_rg_a': nrm(ks[7], (L, LRU_BLOCKS, LRU_BLOCK_WIDTH, LRU_BLOCK_WIDTH), LRU_BLOCK_WIDTH ** -0.5),
        'b_rg_a': nrm(ks[8], (L, LRU_BLOCKS, LRU_BLOCK_WIDTH), 0.01),
        'w_rg_x': nrm(ks[9], (L, LRU_BLOCKS, LRU_BLOCK_WIDTH, LRU_BLOCK_WIDTH), LRU_BLOCK_WIDTH ** -0.5),
        'b_rg_x': nrm(ks[11], (L, LRU_BLOCKS, LRU_BLOCK_WIDTH), 0.01),
        'lru_lambda': lam,
        'attn_sinks': nrm(ks[12], (L, N_Q_HEADS), 1.0),
        'w_attn_proj': nrm(ks[13], (L, Q_WIDTH, D), Q_WIDTH ** -0.5),
        'w_lru_proj': nrm(ks[14], (L, LRU_WIDTH, D), LRU_WIDTH ** -0.5),
        'w_out': nrm(ks[15], (L, D, D), D ** -0.5),
        'norm_ffn_g': 1.0 + nrm(ks[16], (L, D), 0.01),
        'w_router': nrm(ks[17], (L, D, N_EXPERTS), D ** -0.5),
        'b_router': nrm(ks[18], (L, N_EXPERTS), 0.01),
        'w_mlp1': nrm(ks[19], (L, N_EXPERTS, D, 2 * D_EXPERT), D ** -0.5),
        'b_mlp1': nrm(ks[20], (L, N_EXPERTS, 2 * D_EXPERT), 0.01),
        'w_mlp2': nrm(ks[21], (L, N_EXPERTS, D_EXPERT, D), D_EXPERT ** -0.5),
        'b_mlp2': nrm(ks[22], (L, N_EXPERTS, D), 0.01),
        'norm_ple_g': 1.0 + nrm(ks[23], (L, D), 0.01),
        'w_ple': nrm(ks[24], (L, PLE_DIM, D), PLE_DIM ** -0.5),
        'w_ple_gate': nrm(ks[25], (L, D, D), D ** -0.5),
        'norm_final_g': 1.0 + nrm(ks[26], (D,), 0.01),
    }


def reference(x, p, norm_mix_g, w_in, b_in, conv_w, conv_b, w_rg_a, b_rg_a, w_rg_x, b_rg_x,
              lru_lambda, attn_sinks, w_attn_proj, w_lru_proj, w_out, norm_ffn_g, w_router,
              b_router, w_mlp1, b_mlp1, w_mlp2, b_mlp2, norm_ple_g, w_ple, w_ple_gate,
              norm_final_g):
    h = x
    for l in range(DEPTH):
        xn = rmsnorm(h, norm_mix_g[l])
        z = xn @ w_in[l] + b_in[l]
        q, k, v, u, lru_gate, g_attn, g_lru = jnp.split(z, IN_CUTS, axis=-1)
        y_attn = sliding_window_attention(q, k, v, attn_sinks[l])
        y_lru = rglru_branch(u, lru_gate, conv_w[l], conv_b[l], w_rg_a[l], b_rg_a[l],
                             w_rg_x[l], b_rg_x[l], lru_lambda[l])
        merged = (jax.nn.sigmoid(g_attn) * (y_attn @ w_attn_proj[l])
                  + jax.nn.sigmoid(g_lru) * (y_lru @ w_lru_proj[l]))
        h = h + merged @ w_out[l]
        h = h + moe(rmsnorm(h, norm_ffn_g[l]), w_router[l], b_router[l],
                    w_mlp1[l], b_mlp1[l], w_mlp2[l], b_mlp2[l])
        ple_gate = jax.nn.sigmoid(rmsnorm(h, norm_ple_g[l]) @ w_ple_gate[l])
        h = h + ple_gate * (p[l] @ w_ple[l])
    return rmsnorm(h, norm_final_g)
```

```cpp
#include <hip/hip_runtime.h>
#include <stdint.h>
#include <stdio.h>

#ifndef PN8_FIRST
#define PN8_FIRST 0
#endif
#ifndef P1_Q1
#define P1_Q1 7
#endif
#ifndef MK_SINGLE
#define MK_SINGLE 1
#endif

#ifndef ATT_DBG
#define ATT_DBG 0
#endif
#define LAS __attribute__((address_space(3)))
#define GAS __attribute__((address_space(1)))
typedef unsigned short bf16_t;
typedef short bf16x8 __attribute__((ext_vector_type(8)));
typedef float f32x4 __attribute__((ext_vector_type(4)));
typedef float f32x16 __attribute__((ext_vector_type(16)));
typedef unsigned u32x4 __attribute__((ext_vector_type(4)));
typedef unsigned u32x2 __attribute__((ext_vector_type(2)));
typedef int i32x8 __attribute__((ext_vector_type(8)));
typedef int i32x4 __attribute__((ext_vector_type(4)));

constexpr int NTOK = 16384, SEQ = 4096, DM = 2048, INW = 10752;
constexpr int COL_Q = 0, COL_K = 2048, COL_V = 2304, COL_U = 2560, COL_GATE = 4608, COL_GA = 6656, COL_GL = 8704;
constexpr int NEXP = 32, TOPK = 4, DFF = 2048, PLE = 256;
constexpr float RMS_EPS = 1e-6f;
constexpr float QK_SCALE = 0.125f * 1.4426950409f;

constexpr size_t MiB = 1u << 20;
constexpr size_t al(size_t x) { return (x + 4095) & ~(size_t)4095; }
constexpr size_t WS_CTL = 0, CTL_BYTES = 1 * MiB;
constexpr size_t WS_WIN = CTL_BYTES;
constexpr size_t WS_WIN8 = WS_WIN + (size_t)(PN8_FIRST * 256) * DM * 2;
constexpr size_t WS_WAP = WS_WIN + al((size_t)INW * DM * 2);
constexpr size_t WS_WLP = WS_WAP + al((size_t)DM * DM * 2);
constexpr size_t WS_WOUT = WS_WLP + al((size_t)DM * DM * 2);
constexpr size_t WS_WPG = WS_WOUT + al((size_t)DM * DM * 2);
constexpr size_t WS_WPLE = WS_WPG + al((size_t)DM * DM * 2);
constexpr size_t WS_WRG = WS_WPLE + al((size_t)DM * PLE * 2);
constexpr size_t WS_WR = WS_WRG + al((size_t)2 * 8 * 256 * 256 * 2);
constexpr size_t WS_W1 = WS_WR + al((size_t)2 * NEXP * DM * 2);
constexpr size_t WS_W2 = WS_W1 + al((size_t)NEXP * 2 * DFF * DM * 2);
constexpr size_t WS_XB = WS_W2 + al((size_t)NEXP * DM * DFF * 2);
constexpr size_t WS_RSTD1 = WS_XB + al((size_t)NTOK * DM * 2);
constexpr size_t WS_Z = WS_RSTD1 + al((size_t)NTOK * 4);
constexpr size_t WS_YA = WS_Z + al((size_t)NTOK * INW * 2);
constexpr size_t WS_UC = WS_YA + al((size_t)NTOK * DM * 2);
constexpr size_t WS_LA2 = WS_UC + al((size_t)NTOK * DM * 2);
constexpr size_t WS_GG = WS_LA2 + al((size_t)NTOK * DM * 2);
constexpr size_t WS_XIN = WS_GG + al((size_t)NTOK * DM * 2);
constexpr size_t WS_YL = WS_XIN + al((size_t)NTOK * DM * 2);
constexpr size_t WS_M1 = WS_YL + al((size_t)NTOK * DM * 2);
constexpr size_t WS_MG = WS_M1 + al((size_t)NTOK * DM * 4);
constexpr size_t WS_H1 = WS_MG + al((size_t)NTOK * DM * 2);
constexpr size_t WS_H1B = WS_H1 + al((size_t)NTOK * DM * 4);
constexpr size_t WS_TOPW = WS_H1B + al((size_t)NTOK * DM * 2);
constexpr size_t WS_RSTD2 = WS_TOPW + al((size_t)NTOK * 4 * 4);
constexpr size_t WS_RSTD3 = WS_RSTD2 + al((size_t)NTOK * 4);
constexpr size_t WS_ELIST = WS_RSTD3 + al((size_t)NTOK * 4);
constexpr size_t WS_ACT = WS_ELIST + al((size_t)NEXP * NTOK * 4);
constexpr size_t WS_YB = WS_ACT + al((size_t)(NTOK * 4 + 512) * DFF * 2);
constexpr size_t WS_PB = WS_YB + al((size_t)NTOK * 4 * DM * 2);
constexpr size_t WS_PE = WS_PB + al((size_t)NTOK * PLE * 2);
constexpr size_t WS_SS3 = WS_PE + al((size_t)NTOK * DM * 4);
constexpr size_t WS_H1Q = WS_SS3 + al((size_t)NTOK * 32 * 4);
constexpr size_t WS_PRS = WS_H1Q + al((size_t)NTOK * DM);
constexpr size_t WS_PW = WS_PRS + al((size_t)NEXP * NTOK * 4);
constexpr size_t WS_END = WS_PW + al((size_t)NEXP * NTOK * 4);
constexpr int CW_BAR = 1024;
constexpr int CW_ECNT = 8192;
constexpr int CW_QCONV = 12288;
constexpr int CW_QG1 = 12352;

constexpr int NWAVES = 8, NTHR = 512;
constexpr int LDS_BYTES = 147456, MISC_OFF = 146432;

typedef float f32x2 __attribute__((ext_vector_type(2)));
typedef __bf16 bf16v2 __attribute__((ext_vector_type(2)));
__device__ __forceinline__ unsigned pk2(float lo, float hi) { f32x2 f = {lo, hi}; bf16v2 b = __builtin_convertvector(f, bf16v2); return __builtin_bit_cast(unsigned, b); }
__device__ __forceinline__ float bflo(unsigned u) { return __uint_as_float(u << 16); }
__device__ __forceinline__ float bfhi(unsigned u) { return __uint_as_float(u & 0xffff0000u); }
__device__ __forceinline__ float fsigmoid(float x) { return __builtin_amdgcn_rcpf(1.0f + __builtin_amdgcn_exp2f(-1.4426950409f * x)); }
__device__ __forceinline__ float gelu_tanh(float x) { const float t = 0.7978845608f * (x + 0.044715f * x * x * x); return x * fsigmoid(2.0f * t); }
__device__ __forceinline__ float wave_sum(float v) {
#pragma unroll
    for (int o = 1; o < 64; o <<= 1) v += __shfl_xor(v, o);
    return v;
}
#define LDS_WAIT() asm volatile("s_waitcnt lgkmcnt(0)" ::: "memory")
#define VM_WAIT() asm volatile("s_waitcnt vmcnt(0)" ::: "memory")

#define XB_TMO      128
#define XB_XCNT(j)  (256  + 64 * (j))
#define XB_XSUB(j)  (1280 + 64 * (j))
#define XB_XGEN(j)  (2304 + 64 * (j))
#define XB_TOP      3328
#define XB_TOPGEN   3392
#define XCD_BAR_WORDS 3456
#define XB_SPIN_CAP (1u << 18)
__device__ __forceinline__ unsigned xb_ld(unsigned* p)              { return __hip_atomic_load(p, __ATOMIC_RELAXED, __HIP_MEMORY_SCOPE_AGENT); }
__device__ __forceinline__ unsigned xb_add(unsigned* p, unsigned v) { return __hip_atomic_fetch_add(p, v, __ATOMIC_RELAXED, __HIP_MEMORY_SCOPE_AGENT); }
__device__ __forceinline__ unsigned xb_xcc_id() { return (unsigned)__builtin_amdgcn_s_getreg((3 << 11) | 20) & 0xFu; }
#define XB_SPIN(cond, bar) do { unsigned _sp = 0; while (cond) { __builtin_amdgcn_s_sleep(1); \
    if ((++_sp & 255u) == 0u) { if (xb_ld(&(bar)[XB_TMO])) break; if (_sp > XB_SPIN_CAP) { atomicAdd(&(bar)[XB_TMO], 1u); break; } } } } while (0)
struct XcdBarrier { unsigned* bar; unsigned x; volatile LAS unsigned* st; };
__device__ __forceinline__ XcdBarrier xcd_barrier_post(unsigned* bar, volatile LAS unsigned* st) {
    XcdBarrier b; b.bar = bar; b.x = xb_xcc_id(); b.st = st;
    if (threadIdx.x == 0) (void)xb_add(&bar[XB_XCNT(b.x)], 1u);
    return b;
}
__device__ __forceinline__ void xcd_barrier_complete(unsigned* bar, unsigned x, unsigned& nloc, unsigned& nx) {
    const unsigned G = gridDim.x * gridDim.y * gridDim.z;
    unsigned sum, cnt, mine, sp = 0u;
    for (;;) {
        sum = 0u; cnt = 0u; mine = 0u;
#pragma unroll
        for (unsigned j = 0; j < 16; ++j) { const unsigned c = xb_ld(&bar[XB_XCNT(j)]); sum += c; cnt += (c > 0u) ? 1u : 0u; mine = (j == x) ? c : mine; }
        if (sum == G) break;
        __builtin_amdgcn_s_sleep(1);
        if ((++sp & 255u) == 0u) { if (xb_ld(&bar[XB_TMO])) break; if (sp > XB_SPIN_CAP) { atomicAdd(&bar[XB_TMO], 1u); break; } }
    }
    nloc = mine > 0u ? mine : 1u; nx = cnt > 0u ? cnt : 1u;
}
__device__ __forceinline__ void xcd_barrier(const XcdBarrier& b) {
    asm volatile("s_waitcnt vmcnt(0)" ::: "memory");
    __syncthreads();
    if (threadIdx.x == 0) {
        unsigned* bar = b.bar;
        __builtin_amdgcn_s_waitcnt(0);
        unsigned nloc = b.st[0], nx = b.st[1];
        if (nloc == 0u) { xcd_barrier_complete(bar, b.x, nloc, nx); b.st[0] = nloc; b.st[1] = nx; }
        const unsigned old = xb_add(&bar[XB_XSUB(b.x)], 1u);
        const unsigned gen = old / nloc;
        if (old + 1u == (gen + 1u) * nloc) {
            __builtin_amdgcn_fence(__ATOMIC_RELEASE, "agent");
            asm volatile("s_waitcnt vmcnt(0)" ::: "memory");
            const unsigned og = xb_add(&bar[XB_TOP], 1u);
            const unsigned tg = og / nx;
            if (og + 1u == (tg + 1u) * nx) xb_add(&bar[XB_TOPGEN], 1u);
            else XB_SPIN(xb_ld(&bar[XB_TOPGEN]) == tg, bar);
            __builtin_amdgcn_fence(__ATOMIC_ACQUIRE, "agent");
            xb_add(&bar[XB_XGEN(b.x)], 1u);
            asm volatile("s_waitcnt vmcnt(0)" ::: "memory");
        } else {
            XB_SPIN(xb_ld(&bar[XB_XGEN(b.x)]) == gen, bar);
            __builtin_amdgcn_fence(__ATOMIC_ACQUIRE, "agent");
            asm volatile("s_waitcnt vmcnt(0)" ::: "memory");
        }
    }
    __syncthreads();
}

namespace g8 {
constexpr int BM = 256, BK = 64, HALF = 128, HTB = HALF * BK * 2, STAGE_BYTES = 8 * HTB, NXCD = 8, WGM = 8;
__device__ __forceinline__ int lds_byte(int r, int c) { const int st = (r >> 4) * 2 + (c >> 5), rr = r & 15, cc = c & 31, ob = rr * 64 + cc * 2; return st * 1024 + (ob ^ (((ob >> 9) & 1) << 5)); }
__device__ __forceinline__ void stage_rc(int b, int& R, int& C) { const int st = b / 1024, sb = b % 1024, swz = sb ^ (((sb >> 9) & 1) << 5); R = (st >> 1) * 16 + swz / 64; C = (st & 1) * 32 + (swz % 64) / 2; }
__device__ __forceinline__ int perm32(int rho) { const int n = rho >> 4, i = rho & 15; return 8 * (i >> 2) + 4 * n + (i & 3); }

typedef __amdgpu_buffer_rsrc_t Rsrc;
__device__ __forceinline__ Rsrc mk_rsrc(const void* p) {
    const unsigned long long a = (unsigned long long)p; const unsigned lo = __builtin_amdgcn_readfirstlane((unsigned)a), hi = __builtin_amdgcn_readfirstlane((unsigned)(a >> 32));
    return __builtin_amdgcn_make_buffer_rsrc((void*)(((unsigned long long)hi << 32) | lo), 0, 0x7fffffff, 0x00020000); }
__device__ __forceinline__ unsigned voff_b(int tid, int ldbb) { int tz = tid; asm volatile("" : "+v"(tz)); int R, C; stage_rc(tz * 16, R, C); const int Rb = (R & ~31) + perm32(R & 31); return (unsigned)(Rb * ldbb + C * 2); }
struct Unit2 { int pm, pn; };
struct StaticOrder {
    int nM, nN, nwg, G, c;
    __device__ void init(int nM_, int nN_, int G_, int c_) { nM = nM_; nN = nN_; nwg = nM * nN; G = G_; c = c_; }
    __device__ bool next(int i, Unit2& u) const {
        const long L = (long)i * G + c; if (L >= nwg) return false;
        int wgid = (int)L; { const int q = nwg / NXCD, r = nwg % NXCD, xcd = wgid % NXCD, off = wgid / NXCD; wgid = (xcd < r ? xcd * (q + 1) : r * (q + 1) + (xcd - r) * q) + off; }
        const int nig = WGM * nN, gid = wgid / nig, fm = gid * WGM, gsz = (nM - fm) < WGM ? (nM - fm) : WGM;
        u.pm = fm + ((wgid % nig) % gsz); u.pn = (wgid % nig) / gsz; return true;
    }
};

template <class P>
__device__ __forceinline__ void gemm_phase(LAS unsigned char* lds, const P& p) {
    int tid = threadIdx.x; asm volatile("" : "+v"(tid));
    const int wid = __builtin_amdgcn_readfirstlane(tid >> 6), lane = tid & 63, wr = wid >> 2, wc = wid & 3, fr = lane & 15, fq = lane >> 4;
    const unsigned ldsw = (unsigned)wid * 1024u;
    int aoff = lds_byte(wr * 64 + fr, fq * 8), boff = lds_byte(wc * 32 + fr, fq * 8) + 4 * HTB;
    asm volatile("" : "+v"(aoff), "+v"(boff));
    const LAS unsigned char* ldsA = lds + aoff; const LAS unsigned char* ldsB = lds + boff;
#define G8_SA(b, h) (((b) * 2 + (h)) * HTB)
#define G8_SB(b, h) ((4 + (b) * 2 + (h)) * HTB)
#define G8_STAGE1(bufoff, rs, vo, so) __builtin_amdgcn_raw_ptr_buffer_load_lds(rs, (LAS void*)(lds + (bufoff) + ldsw), 16, (int)(vo), (int)(so), 0, 0)
#define G8_STAGE_B(bufoff, so) do { G8_STAGE1(bufoff, rB, voffB, so); G8_STAGE1((bufoff) + 8192, rB, voffB, (so) + b64); } while (0)
#define G8_STAGE_A(bufoff, rs, o, h, so) do { if constexpr (P::GATHER) { G8_STAGE1(bufoff, rs, o[2 * (h)], so); G8_STAGE1((bufoff) + 8192, rs, o[2 * (h) + 1], so); } \
        else { G8_STAGE1(bufoff, rs, o[0], (so) + (h) * 2 * a64); G8_STAGE1((bufoff) + 8192, rs, o[0], (so) + ((h) * 2 + 1) * a64); } } while (0)
#define G8_LD8(dst, base, off) do { const i32x4 _lo = *(const LAS i32x4*)((base) + (off)), _hi = *(const LAS i32x4*)((base) + (off) + 1024); dst = __builtin_shufflevector(_lo, _hi, 0, 1, 2, 3, 4, 5, 6, 7); } while (0)
#define G8_LDA(dst, b, h) do { _Pragma("unroll") for (int m = 0; m < 4; ++m) G8_LD8(dst[m], ldsA, G8_SA(b, h) + m * 2048); } while (0)
#define G8_LDB(dst, b, h) do { _Pragma("unroll") for (int n = 0; n < 2; ++n) G8_LD8(dst[n], ldsB, G8_SB(b, h) - 4 * HTB + n * 2048); } while (0)
#define G8_H(v, k) __builtin_bit_cast(bf16x8, __builtin_shufflevector(v, v, 4 * (k), 4 * (k) + 1, 4 * (k) + 2, 4 * (k) + 3))
#define G8_MMA(ai, bj, At, Bt) do { __builtin_amdgcn_s_setprio(1); \
        if constexpr (P::FP8) { _Pragma("unroll") for (int m = 0; m < 4; ++m) _Pragma("unroll") for (int n = 0; n < 2; ++n) \
            acc[ai][bj][m][n] = __builtin_amdgcn_mfma_scale_f32_16x16x128_f8f6f4(Bt[n], At[m], acc[ai][bj][m][n], 0, 0, 0, 0, 0, 0); } \
        else { _Pragma("unroll") for (int m = 0; m < 4; ++m) _Pragma("unroll") for (int n = 0; n < 2; ++n) { \
            acc[ai][bj][m][n] = __builtin_amdgcn_mfma_f32_16x16x32_bf16(G8_H(Bt[n], 0), G8_H(At[m], 0), acc[ai][bj][m][n], 0, 0, 0); \
            acc[ai][bj][m][n] = __builtin_amdgcn_mfma_f32_16x16x32_bf16(G8_H(Bt[n], 1), G8_H(At[m], 1), acc[ai][bj][m][n], 0, 0, 0); } } \
        __builtin_amdgcn_s_setprio(0); } while (0)
#define G8_WAIT_V(n) asm volatile("s_waitcnt vmcnt(" #n ")" ::: "memory")
#define G8_WAIT_L(n) asm volatile("s_waitcnt lgkmcnt(" #n ")" ::: "memory")
#define G8_BAR __builtin_amdgcn_s_barrier()
#define G8_SCHED __builtin_amdgcn_sched_barrier(0)
    typename P::Unit cur, nxt; int ui = 0;
    if (!p.next(0, cur)) return;
    i32x8 At[4], B0[2], B1[2];
    Rsrc rA, rB; int dB, a64, b64, nt; unsigned voffB; unsigned oA[P::GATHER ? 4 : 1];
    p.setup(cur, tid, rA, rB, dB, oA, voffB, a64, b64); nt = p.ntiles(cur);
    G8_STAGE_B(G8_SB(0, 0), 0); G8_STAGE_B(G8_SB(0, 1), dB); G8_STAGE_A(G8_SA(0, 0), rA, oA, 0, 0); G8_STAGE_A(G8_SA(0, 1), rA, oA, 1, 0);
    if (wr == 1) G8_BAR;
    G8_WAIT_V(2); G8_BAR;
    G8_STAGE_B(G8_SB(1, 0), 128); G8_STAGE_A(G8_SA(1, 0), rA, oA, 0, 128); G8_STAGE_B(G8_SB(1, 1), dB + 128);
    G8_WAIT_V(6); G8_BAR;
    f32x4 acc[2][2][4][2];
#pragma unroll
    for (int a = 0; a < 2; ++a)
#pragma unroll
        for (int b = 0; b < 2; ++b)
#pragma unroll
            for (int m = 0; m < 4; ++m)
#pragma unroll
                for (int n = 0; n < 2; ++n) acc[a][b][m][n] = (f32x4){0.f, 0.f, 0.f, 0.f};
    for (;;) {
        const bool has_next = p.next(ui + 1, nxt);
#pragma unroll 1
        for (int t = 0; t < nt; t += 2) {
            const bool last = (t == nt - 2);
            G8_STAGE_A(G8_SA(1, 1), rA, oA, 1, (t + 1) * 128);
            int k2 = (t + 2) * 128;
            if (last) { k2 = 0; if (has_next) p.setup(nxt, tid, rA, rB, dB, oA, voffB, a64, b64); }
            G8_LDB(B0, 0, 0); G8_LDB(B1, 0, 1); G8_SCHED; G8_LDA(At, 0, 0);
            G8_WAIT_V(8); G8_WAIT_L(0); G8_BAR; G8_MMA(0, 0, At, B0); G8_MMA(0, 1, At, B1); G8_BAR; G8_SCHED;
            G8_LDA(At, 0, 1); G8_STAGE_B(G8_SB(0, 0), k2); G8_STAGE_B(G8_SB(0, 1), dB + k2); G8_STAGE_A(G8_SA(0, 0), rA, oA, 0, k2);
            G8_WAIT_V(8); G8_WAIT_L(0); G8_BAR; G8_MMA(1, 0, At, B0); G8_MMA(1, 1, At, B1); G8_BAR; G8_SCHED;
            G8_LDB(B0, 1, 0); G8_LDB(B1, 1, 1); G8_SCHED; G8_LDA(At, 1, 0); G8_STAGE_A(G8_SA(0, 1), rA, oA, 1, k2);
            G8_WAIT_V(8); G8_WAIT_L(0); G8_BAR; G8_MMA(0, 0, At, B0); G8_MMA(0, 1, At, B1); G8_BAR; G8_SCHED;
            G8_LDA(At, 1, 1); G8_STAGE_B(G8_SB(1, 0), k2 + 128); G8_STAGE_B(G8_SB(1, 1), dB + k2 + 128); G8_STAGE_A(G8_SA(1, 0), rA, oA, 0, k2 + 128);
            G8_WAIT_V(8); G8_WAIT_L(0); G8_BAR; G8_MMA(1, 0, At, B0); G8_MMA(1, 1, At, B1); G8_BAR; G8_SCHED;
        }
        if (wr == 0) G8_BAR;
        {
            int tz = threadIdx.x; asm volatile("" : "+v"(tz));
            const int lz = tz & 63, wz = __builtin_amdgcn_readfirstlane(tz >> 6);
            p.epi(acc, cur, wz >> 2, wz & 3, lz & 15, lz >> 4);
        }
        if (!has_next) break;
        if (!p.keep_acc(cur)) {
#pragma unroll
        for (int a = 0; a < 2; ++a)
#pragma unroll
            for (int b = 0; b < 2; ++b)
#pragma unroll
                for (int m = 0; m < 4; ++m)
#pragma unroll
                    for (int n = 0; n < 2; ++n) acc[a][b][m][n] = (f32x4){0.f, 0.f, 0.f, 0.f};
        }
        cur = nxt; ++ui; nt = p.ntiles(cur);
        if (wr == 1) G8_BAR;
    }
    G8_WAIT_V(0);
    G8_BAR;
#undef G8_SA
#undef G8_SB
#undef G8_STAGE1
#undef G8_STAGE_A
#undef G8_STAGE_B
#undef G8_LDA
#undef G8_LD8
#undef G8_H
#undef G8_LDB
#undef G8_MMA
#undef G8_WAIT_V
#undef G8_WAIT_L
#undef G8_BAR
#undef G8_SCHED
}

template <int LDA_, int LDB_, int K_>
struct DenseBase {
    static constexpr int K = K_, LDA = LDA_, LDB = LDB_, LDBB = LDB_ * 2, LDAB = LDA_ * 2;
    static constexpr bool FP8 = false, GATHER = false;
    typedef Unit2 Unit;
    StaticOrder S; const bf16_t* A; const bf16_t* Bt;
    __device__ __forceinline__ bool next(int i, Unit& u) const { return S.next(i, u); }
    __device__ __forceinline__ bool keep_acc(const Unit&) const { return false; }
    __device__ __forceinline__ int ntiles(const Unit&) const { return K * 2 / 128; }
    __device__ __forceinline__ void setup(const Unit& u, int tid, Rsrc& ra, Rsrc& rb, int& db, unsigned (&o)[1], unsigned& vb, int& a64, int& b64) const {
        vb = voff_b(tid, LDBB); a64 = 64 * LDAB; b64 = 64 * LDBB;
        ra = mk_rsrc((const char*)A + (size_t)u.pm * 256 * LDA * 2);
        { int tz = tid; asm volatile("" : "+v"(tz)); int R, C; stage_rc(tz * 16, R, C); o[0] = (unsigned)(R * LDA + C) * 2u; }
        rb = mk_rsrc((const char*)Bt + (size_t)u.pn * 256 * LDB * 2); db = 128 * LDB * 2;
    }
};
}
using g8::gemm_phase;
typedef f32x4 Acc[2][2][4][2];

__device__ __forceinline__ f32x4 ld4(const float* p) { return *(const GAS f32x4*)p; }
__device__ __forceinline__ void st4(float* p, f32x4 v) { *(GAS f32x4*)p = v; }
__device__ __forceinline__ u32x4 ld16(const bf16_t* p) { return *(const GAS u32x4*)p; }
__device__ __forceinline__ void st16(bf16_t* p, u32x4 v) { *(GAS u32x4*)p = v; }
__device__ __forceinline__ u32x4 pack8(f32x4 a, f32x4 b) { u32x4 w; w.x = pk2(a[0], a[1]); w.y = pk2(a[2], a[3]); w.z = pk2(b[0], b[1]); w.w = pk2(b[2], b[3]); return w; }
__device__ __forceinline__ void unpack8(u32x4 w, f32x4& a, f32x4& b) { a = (f32x4){bflo(w.x), bfhi(w.x), bflo(w.y), bfhi(w.y)}; b = (f32x4){bflo(w.z), bfhi(w.z), bflo(w.w), bfhi(w.w)}; }

__device__ __forceinline__ u32x2 pack8_fp8(f32x4 a, f32x4 b) { int w0 = 0, w1 = 0;
#pragma unroll
    for (int j = 0; j < 4; ++j) { a[j] = __builtin_amdgcn_fmed3f(a[j], -448.0f, 448.0f); b[j] = __builtin_amdgcn_fmed3f(b[j], -448.0f, 448.0f); }
    w0 = __builtin_amdgcn_cvt_pk_fp8_f32(a[0], a[1], w0, false); w0 = __builtin_amdgcn_cvt_pk_fp8_f32(a[2], a[3], w0, true);
    w1 = __builtin_amdgcn_cvt_pk_fp8_f32(b[0], b[1], w1, false); w1 = __builtin_amdgcn_cvt_pk_fp8_f32(b[2], b[3], w1, true);
    u32x2 r; r.x = (unsigned)w0; r.y = (unsigned)w1; return r; }
__device__ __forceinline__ void st8(unsigned char* p, u32x2 v) { *(GAS u32x2*)p = v; }
__device__ __forceinline__ void unpack8_fp8(u32x2 w, f32x4& a, f32x4& b) { const f32x2 a0 = __builtin_amdgcn_cvt_pk_f32_fp8((int)w.x, false), a1 = __builtin_amdgcn_cvt_pk_f32_fp8((int)w.x, true), b0 = __builtin_amdgcn_cvt_pk_f32_fp8((int)w.y, false), b1 = __builtin_amdgcn_cvt_pk_f32_fp8((int)w.y, true);
    a = (f32x4){a0[0], a0[1], a1[0], a1[1]}; b = (f32x4){b0[0], b0[1], b1[0], b1[1]}; }
constexpr float W8_SCALE = 64.0f, ACT8_SCALE = 4.0f, YB8_SCALE = 32.0f, Y8_SCALE = 16.0f;

struct DynOrder8 {
    unsigned* q; volatile LAS int* slot; int x0; mutable int quota; int nper, pn0;
    __device__ __forceinline__ bool next(int, g8::Unit2& u) const {
        if (quota <= 0) return false;
        --quota;
        if (threadIdx.x == 0) { int L = -1;
            for (int k = 0; k < 8; ++k) { const int x = (x0 + k) & 7; const unsigned v = __hip_atomic_fetch_add(q + 64 * x, 1u, __ATOMIC_RELAXED, __HIP_MEMORY_SCOPE_AGENT); if (v < (unsigned)nper) { L = (x << 16) | (int)v; break; } }
            *slot = L; }
        asm volatile("s_waitcnt lgkmcnt(0)" ::: "memory"); __builtin_amdgcn_s_barrier(); asm volatile("" ::: "memory");
        const int L = __builtin_amdgcn_readfirstlane(*slot);
        if (L < 0) return false;
        const int x = L >> 16, i = L & 0xffff; u.pm = 8 * x + (i & 7); u.pn = pn0 + (i >> 3); return true;
    }
};

__device__ __forceinline__ size_t cg_index(int row, int c) { return ((size_t)((row >> 12) * 64 + (c >> 5)) * SEQ + (row & (SEQ - 1))) * 32 + (c & 31); }

template <int MODE> struct ProbInProjT : g8::DenseBase<DM, DM, DM> {
    const float* rstd; const float* bias; bf16_t* Z; bf16_t* GG; DynOrder8 D;
    __device__ __forceinline__ bool next(int i, Unit& u) const { return D.next(i, u); }
    __device__ __forceinline__ void epi(Acc& acc, const Unit& u, int wr, int wc, int fr, int fq) const {
        if (MODE == 2) { f32x4 t = {0.f, 0.f, 0.f, 0.f};
#pragma unroll
            for (int a_ = 0; a_ < 2; ++a_)
#pragma unroll
                for (int b_ = 0; b_ < 2; ++b_)
#pragma unroll
                    for (int m_ = 0; m_ < 4; ++m_)
#pragma unroll
                        for (int n_ = 0; n_ < 2; ++n_) t += acc[a_][b_][m_][n_];
            if (t[0] + t[1] + t[2] + t[3] == 1.2345e30f) Z[0] = 1; return; }
        const int colt = u.pn * 256; const int kind = (MODE == 1) ? 0 : (colt < COL_GATE ? 0 : (colt < COL_GA ? 1 : 2));
        const int row0 = u.pm * 256 + wr * 64 + fr, col0 = colt + wc * 32 + 8 * fq;
        f32x4 bv[2][2];
#pragma unroll
        for (int bj = 0; bj < 2; ++bj) { bv[bj][0] = ld4(bias + col0 + bj * 128); bv[bj][1] = ld4(bias + col0 + bj * 128 + 4); }
        float rsv[8];
#pragma unroll
        for (int q = 0; q < 8; ++q) rsv[q] = rstd[row0 + (q >> 2) * 128 + (q & 3) * 16];
#pragma unroll
        for (int ai = 0; ai < 2; ++ai)
#pragma unroll
            for (int m = 0; m < 4; ++m) {
                const int row = row0 + ai * 128 + m * 16; const float rs = rsv[ai * 4 + m];
#pragma unroll
                for (int bj = 0; bj < 2; ++bj) {
                    f32x4 v0 = acc[ai][bj][m][0] * rs + bv[bj][0], v1 = acc[ai][bj][m][1] * rs + bv[bj][1];
                    if (colt < COL_K) { v0 *= QK_SCALE; v1 *= QK_SCALE; }
                    if (kind == 1) {
#pragma unroll
                        for (int j = 0; j < 4; ++j) { v0[j] = gelu_tanh(v0[j]); v1[j] = gelu_tanh(v1[j]); }
                    } else if (kind == 2) {
#pragma unroll
                        for (int j = 0; j < 4; ++j) { v0[j] = fsigmoid(v0[j]); v1[j] = fsigmoid(v1[j]); }
                    }
#ifdef P1_NT
                    if (kind == 1) __builtin_nontemporal_store(pack8(v0, v1), (GAS u32x4*)(GG + cg_index(row, col0 + bj * 128 - COL_GATE)));
                    else __builtin_nontemporal_store(pack8(v0, v1), (GAS u32x4*)(Z + (size_t)row * INW + col0 + bj * 128));
#else
                    if (kind == 1) st16(GG + cg_index(row, col0 + bj * 128 - COL_GATE), pack8(v0, v1));
                    else st16(Z + (size_t)row * INW + col0 + bj * 128, pack8(v0, v1));
#endif
                }
            }
    }
};

typedef ProbInProjT<0> ProbInProj;

constexpr float X8_SCALE = 8.0f;
constexpr int PN_GA = PN8_FIRST, COL8 = PN8_FIRST * 256, NCOL8 = INW - COL8;
struct ProbInProj8 {
    static constexpr bool FP8 = true, GATHER = false;
    typedef g8::Unit2 Unit;
    const unsigned char *XQ, *W8; const float* rstd; const float* bias; bf16_t* Z; bf16_t* GG; DynOrder8 D;
    __device__ __forceinline__ bool next(int i, Unit& u) const { return D.next(i, u); }
    __device__ __forceinline__ bool keep_acc(const Unit&) const { return false; }
    __device__ __forceinline__ int ntiles(const Unit&) const { return DM / 128; }
    __device__ __forceinline__ void setup(const Unit& u, int tid, g8::Rsrc& ra, g8::Rsrc& rb, int& db, unsigned (&o)[1], unsigned& vb, int& a64, int& b64) const {
        vb = g8::voff_b(tid, DM); a64 = 64 * DM; b64 = 64 * DM;
        ra = g8::mk_rsrc((const char*)XQ + (size_t)u.pm * 256 * DM);
        { int tz = tid; asm volatile("" : "+v"(tz)); int R, C; g8::stage_rc(tz * 16, R, C); o[0] = (unsigned)(R * DM + C * 2); }
        rb = g8::mk_rsrc((const char*)W8 + (size_t)(u.pn - PN_GA) * 256 * DM); db = 128 * DM;
    }
    __device__ __forceinline__ void epi(Acc& acc, const Unit& u, int wr, int wc, int fr, int fq) const {
        const int colt = u.pn * 256; const int row0 = u.pm * 256 + wr * 64 + fr, col0 = colt + wc * 32 + 8 * fq;
        const int kind = colt < COL_GATE ? 0 : (colt < COL_GA ? 1 : 2);
        f32x4 bv[2][2];
#pragma unroll
        for (int bj = 0; bj < 2; ++bj) { bv[bj][0] = ld4(bias + col0 + bj * 128); bv[bj][1] = ld4(bias + col0 + bj * 128 + 4); }
        float rsv[8];
#pragma unroll
        for (int q = 0; q < 8; ++q) rsv[q] = rstd[row0 + (q >> 2) * 128 + (q & 3) * 16] * (1.0f / (X8_SCALE * W8_SCALE));
#pragma unroll
        for (int ai = 0; ai < 2; ++ai)
#pragma unroll
            for (int m = 0; m < 4; ++m) {
                const int row = row0 + ai * 128 + m * 16; const float rs = rsv[ai * 4 + m];
#pragma unroll
                for (int bj = 0; bj < 2; ++bj) {
                    f32x4 v0 = acc[ai][bj][m][0] * rs + bv[bj][0], v1 = acc[ai][bj][m][1] * rs + bv[bj][1];
                    if (colt < COL_K) { v0 *= QK_SCALE; v1 *= QK_SCALE; }
                    if (kind == 1) {
#pragma unroll
                        for (int j = 0; j < 4; ++j) { v0[j] = gelu_tanh(v0[j]); v1[j] = gelu_tanh(v1[j]); }
                    } else if (kind == 2) {
#pragma unroll
                        for (int j = 0; j < 4; ++j) { v0[j] = fsigmoid(v0[j]); v1[j] = fsigmoid(v1[j]); }
                    }
                    if (kind == 1) st16(GG + cg_index(row, col0 + bj * 128 - COL_GATE), pack8(v0, v1));
                    else st16(Z + (size_t)row * INW + col0 + bj * 128, pack8(v0, v1));
                }
            }
    }
};

struct UnitG { int pm, n, ch; };
struct ProbGates {
    static constexpr int K = 256, LDBB = 512, LDAB = DM * 2;
    static constexpr bool FP8 = false, GATHER = false;
    typedef UnitG Unit;
    __device__ __forceinline__ bool keep_acc(const Unit&) const { return false; }
    int G, c; const bf16_t* UC; const bf16_t* W; const float *b_a, *b_x, *lam; bf16_t* LA2; bf16_t* XIN;
    __device__ __forceinline__ bool next(int i, Unit& u) const { const int L = i * G + c; if (L >= 1024) return false; u.ch = L & 1; u.n = (L >> 1) & 7; u.pm = L >> 4; return true; }
    __device__ __forceinline__ int ntiles(const Unit&) const { return K * 2 / 128; }
    __device__ __forceinline__ void setup(const Unit& u, int tid, g8::Rsrc& ra, g8::Rsrc& rb, int& db, unsigned (&o)[1], unsigned& vb, int& a64, int& b64) const {
        vb = g8::voff_b(tid, LDBB); a64 = 64 * LDAB; b64 = 64 * LDBB;
        ra = g8::mk_rsrc((const char*)UC + ((size_t)u.pm * 256 * DM + u.n * 256) * 2);
        { int tz = tid; asm volatile("" : "+v"(tz)); int R, C; g8::stage_rc(tz * 16, R, C); o[0] = (unsigned)(R * DM + C) * 2u; }
        rb = g8::mk_rsrc((const char*)W + ((size_t)(u.n * 256 + u.ch * 128) * 256) * 2); db = 8 * 256 * 256 * 2;
    }
    __device__ __forceinline__ void epi(Acc& acc, const Unit& u, int wr, int wc, int fr, int fq) const {
        const int ch0 = u.n * 256 + u.ch * 128 + wc * 32 + 8 * fq;
        const int row0 = u.pm * 256 + wr * 64 + fr;
        f32x4 ba[2], bx[2], sp[2];
#pragma unroll
        for (int n = 0; n < 2; ++n) { ba[n] = ld4(b_a + ch0 + 4 * n); bx[n] = ld4(b_x + ch0 + 4 * n); const f32x4 l = ld4(lam + ch0 + 4 * n);
#pragma unroll
            for (int j = 0; j < 4; ++j) { const float z = -l[j]; sp[n][j] = (z > 15.f) ? z : log1pf(__expf(z)); } }
        u32x4 ucv[8];
#pragma unroll
        for (int q = 0; q < 8; ++q) ucv[q] = ld16(UC + (size_t)(row0 + (q >> 2) * 128 + (q & 3) * 16) * DM + ch0);
#pragma unroll
        for (int ai = 0; ai < 2; ++ai)
#pragma unroll
            for (int m = 0; m < 4; ++m) {
                const int row = row0 + ai * 128 + m * 16; const bool first = (row & (SEQ - 1)) == 0;
                f32x4 uc0, uc1; unpack8(ucv[ai * 4 + m], uc0, uc1);
                f32x4 av[2], xv[2];
#pragma unroll
                for (int n = 0; n < 2; ++n)
#pragma unroll
                    for (int j = 0; j < 4; ++j) {
                        const float ea = 1.0f + __builtin_amdgcn_exp2f(-1.4426950409f * (acc[ai][0][m][n][j] + ba[n][j])), ex = 1.0f + __builtin_amdgcn_exp2f(-1.4426950409f * (acc[ai][1][m][n][j] + bx[n][j]));
                        const float tt = __builtin_amdgcn_rcpf(ea * ex); const float r = tt * ex, ig = tt * ea;
                        const float la = -8.0f * r * sp[n][j];
                        const float x2 = 2.0f * la; const float em = (x2 > -0.5f) ? -x2 * (1.0f + x2 * (0.5f + x2 * (0.16666667f + x2 * (0.041666668f + x2 * (0.0083333338f + x2 * 0.0013888889f))))) : 1.0f - __expf(x2);
                        const float mult = first ? 1.0f : __builtin_amdgcn_sqrtf(em);
                        av[n][j] = la * 1.4426950409f; xv[n][j] = mult * ig * (n == 0 ? uc0[j] : uc1[j]);
                    }
                const size_t o = cg_index(row, ch0);
                st16(LA2 + o, pack8(av[0], av[1])); st16(XIN + o, pack8(xv[0], xv[1]));
                __builtin_amdgcn_sched_barrier(0);
            }
    }
};

struct UnitP { int pm, pn, part; };
struct ProbProj2 {
    static constexpr int K = DM, LDBB = DM, LDAB = DM;
    static constexpr bool FP8 = true, GATHER = false;
    typedef UnitP Unit;
    g8::StaticOrder S; const bf16_t *YA, *YL, *WA, *WL, *Z; bf16_t* MG;
    __device__ __forceinline__ bool next(int i, Unit& u) const { g8::Unit2 t; if (!S.next(i >> 1, t)) return false; u.pm = t.pm; u.pn = t.pn; u.part = i & 1; return true; }
    __device__ __forceinline__ bool keep_acc(const Unit& u) const { return u.part == 0; }
    __device__ __forceinline__ int ntiles(const Unit&) const { return K / 128; }
    __device__ __forceinline__ void setup(const Unit& u, int tid, g8::Rsrc& ra, g8::Rsrc& rb, int& db, unsigned (&o)[1], unsigned& vb, int& a64, int& b64) const {
        vb = g8::voff_b(tid, LDBB); a64 = 64 * LDAB; b64 = 64 * LDBB;
        ra = g8::mk_rsrc((const char*)(u.part ? YL : YA) + (size_t)u.pm * 256 * DM);
        { int tz = tid; asm volatile("" : "+v"(tz)); int R, C; g8::stage_rc(tz * 16, R, C); o[0] = (unsigned)(R * DM + C * 2); }
        rb = g8::mk_rsrc((const char*)(u.part ? WL : WA) + (size_t)u.pn * 256 * DM); db = 128 * DM;
    }
    __device__ __forceinline__ void epi(Acc& acc, const Unit& u, int wr, int wc, int fr, int fq) const {
        const int row0 = u.pm * 256 + wr * 64 + fr, col0 = u.pn * 256 + wc * 32 + 8 * fq;
        if (u.part == 0) {
#pragma unroll
            for (int ai = 0; ai < 2; ++ai)
#pragma unroll
                for (int m = 0; m < 4; ++m) {
                    const int row = row0 + ai * 128 + m * 16;
#pragma unroll
                    for (int bj = 0; bj < 2; ++bj) {
                        const int col = col0 + bj * 128;
                        f32x4 l0, l1, a0, a1; unpack8(ld16(Z + (size_t)row * INW + COL_GL + col), l0, l1); unpack8(ld16(Z + (size_t)row * INW + COL_GA + col), a0, a1);
#pragma unroll
                        for (int j = 0; j < 4; ++j) { acc[ai][bj][m][0][j] *= a0[j] * __builtin_amdgcn_rcpf(l0[j]); acc[ai][bj][m][1][j] *= a1[j] * __builtin_amdgcn_rcpf(l1[j]); }
                    }
                }
        } else {
            u32x4 gl[8][2];
#pragma unroll
            for (int q = 0; q < 8; ++q)
#pragma unroll
                for (int bj = 0; bj < 2; ++bj) gl[q][bj] = ld16(Z + (size_t)(row0 + (q >> 2) * 128 + (q & 3) * 16) * INW + COL_GL + col0 + bj * 128);
#pragma unroll
            for (int ai = 0; ai < 2; ++ai)
#pragma unroll
                for (int m = 0; m < 4; ++m) {
                    const int row = row0 + ai * 128 + m * 16;
#pragma unroll
                    for (int bj = 0; bj < 2; ++bj) { f32x4 l0, l1; unpack8(gl[ai * 4 + m][bj], l0, l1);
                        st16(MG + (size_t)row * DM + col0 + bj * 128, pack8(acc[ai][bj][m][0] * (l0 * (1.0f / (Y8_SCALE * W8_SCALE))), acc[ai][bj][m][1] * (l1 * (1.0f / (Y8_SCALE * W8_SCALE))))); }
                }
        }
    }
};

struct ProbOut : g8::DenseBase<DM, DM, DM> {
    const float* X; float* H1; unsigned char* H1Q;
    __device__ __forceinline__ void epi(Acc& acc, const Unit& u, int wr, int wc, int fr, int fq) const {
        const int row0 = u.pm * 256 + wr * 64 + fr, col0 = u.pn * 256 + wc * 32 + 8 * fq;
        f32x4 xn[4];
#pragma unroll
        for (int t = 0; t < 4; ++t) xn[t] = ld4(X + (size_t)row0 * DM + col0 + (t >> 1) * 128 + (t & 1) * 4);
#pragma unroll
        for (int q = 0; q < 8; ++q) {
            const int ai = q >> 2, m = q & 3; const int row = row0 + ai * 128 + m * 16;
            f32x4 xc[4];
#pragma unroll
            for (int t = 0; t < 4; ++t) xc[t] = xn[t];
            if (q < 7) { const int rn = row0 + ((q + 1) >> 2) * 128 + ((q + 1) & 3) * 16;
#pragma unroll
                for (int t = 0; t < 4; ++t) xn[t] = ld4(X + (size_t)rn * DM + col0 + (t >> 1) * 128 + (t & 1) * 4); }
#pragma unroll
            for (int bj = 0; bj < 2; ++bj) {
                const size_t o = (size_t)row * DM + col0 + bj * 128;
                const f32x4 v0 = acc[ai][bj][m][0] + xc[2 * bj], v1 = acc[ai][bj][m][1] + xc[2 * bj + 1];
                st4(H1 + o, v0); st4(H1 + o + 4, v1); st8(H1Q + o, pack8_fp8(v0, v1));
            }
        }
    }
};

struct UnitM { int e, rt, ct, cnt, base; };
template <int NCT_LOG2>
__device__ __forceinline__ bool moe_next(const volatile LAS int* tab, int i, int G, int c, UnitM& u) {
    int ct, g;
    if (G == 256) { const int x = c & 7, j = c >> 3;
        if (NCT_LOG2 == 4) { ct = 4 * (x & 3) + (j & 3); g = i * 16 + 8 * (x >> 2) + (j >> 2); }
        else { ct = 4 * (x & 1) + (j & 3); g = i * 32 + 8 * (x >> 1) + (j >> 2); } }
    else { const int L = i * G + c; ct = L & ((1 << NCT_LOG2) - 1); g = L >> NCT_LOG2; }
    if (g >= __builtin_amdgcn_readfirstlane(tab[32])) return false;
    const int e = __builtin_amdgcn_readfirstlane((int)((const volatile LAS unsigned char*)tab)[576 + g]);
    u.e = e; u.rt = g - __builtin_amdgcn_readfirstlane(tab[e]); u.ct = ct; u.base = __builtin_amdgcn_readfirstlane(tab[33 + e]); u.cnt = __builtin_amdgcn_readfirstlane(tab[33 + e + 1]) - u.base; return true;
}
struct ProbMoe1 {
    static constexpr int K = DM, LDBB = DM, LDAB = DM;
    static constexpr bool FP8 = true, GATHER = true;
    typedef UnitM Unit;
    __device__ __forceinline__ bool keep_acc(const Unit&) const { return false; }
    int G, c; const volatile LAS int* tab; const unsigned char* H1Q; const unsigned char* W1; const int* elist; const float* rstd2; const float* prs; const float* b1; unsigned char* ACT;
    __device__ __forceinline__ bool next(int i, Unit& u) const { return moe_next<4>(tab, i, G, c, u); }
    __device__ __forceinline__ int ntiles(const Unit&) const { return K / 128; }
    __device__ __forceinline__ void setup(const Unit& u, int tid, g8::Rsrc& ra, g8::Rsrc& rb, int& db, unsigned (&o)[4], unsigned& vb, int& a64, int& b64) const {
        vb = g8::voff_b(tid, LDBB); a64 = 64 * LDAB; b64 = 64 * LDBB;
        ra = g8::mk_rsrc(H1Q); const int* el = elist + (size_t)u.e * NTOK;
        int tz = tid; asm volatile("" : "+v"(tz));
        int R, C; g8::stage_rc(tz * 16, R, C);
#pragma unroll
        for (int q = 0; q < 4; ++q) { const int pq = u.rt * 256 + R + 64 * (q & 1) + 128 * (q >> 1); const int sq = el[pq < u.cnt ? pq : 0] & 0xffff; o[q] = (unsigned)((sq >> 2) * DM + C * 2); }
        rb = g8::mk_rsrc((const char*)W1 + ((size_t)u.e * 2 * DFF + u.ct * 128) * DM); db = DFF * DM;
    }
    __device__ __forceinline__ void epi(Acc& acc, const Unit& u, int wr, int wc, int fr, int fq) const {
        const int gc = u.ct * 128 + wc * 32 + 8 * fq; const float* bb = b1 + (size_t)u.e * 2 * DFF;
        const f32x4 bg0 = ld4(bb + gc), bg1 = ld4(bb + gc + 4), bl0 = ld4(bb + DFF + gc), bl1 = ld4(bb + DFF + gc + 4);
        const int* el = elist + (size_t)u.e * NTOK;
#pragma unroll
        for (int ai = 0; ai < 2; ++ai) {
            float rsv[4];
#pragma unroll
            for (int q = 0; q < 4; ++q) { const int pos = u.rt * 256 + ai * 128 + wr * 64 + q * 16 + fr; rsv[q] = prs[(size_t)u.e * NTOK + (pos < u.cnt ? pos : 0)] * (1.0f / W8_SCALE); }
#pragma unroll
            for (int m = 0; m < 4; ++m) {
                const int pos = u.rt * 256 + ai * 128 + wr * 64 + m * 16 + fr; const float rs = rsv[m];
                f32x4 g0 = acc[ai][0][m][0] * rs + bg0, g1 = acc[ai][0][m][1] * rs + bg1, l0 = acc[ai][1][m][0] * rs + bl0, l1 = acc[ai][1][m][1] * rs + bl1;
#pragma unroll
                for (int j = 0; j < 4; ++j) {
                    float g = fminf(g0[j], 7.0f), l = fminf(fmaxf(l0[j], -7.0f), 7.0f); g0[j] = g * fsigmoid(1.702f * g) * (l + 1.0f) * ACT8_SCALE;
                    g = fminf(g1[j], 7.0f); l = fminf(fmaxf(l1[j], -7.0f), 7.0f); g1[j] = g * fsigmoid(1.702f * g) * (l + 1.0f) * ACT8_SCALE;
                }
                if (pos < u.cnt) st8(ACT + (size_t)(u.base + pos) * DFF + gc, pack8_fp8(g0, g1));
            }
        }
    }
};
template <int STUB> struct ProbMoe2T {
    static constexpr int K = DFF, LDBB = DFF, LDAB = DFF;
    static constexpr bool FP8 = true, GATHER = false;
    typedef UnitM Unit;
    __device__ __forceinline__ bool keep_acc(const Unit&) const { return false; }
    int G, c; const volatile LAS int* tab; const unsigned char* ACT; const unsigned char* W2; const int* elist; const float* topw; const float* pw; const float* b2; unsigned char* YB;
    __device__ __forceinline__ bool next(int i, Unit& u) const { return moe_next<3>(tab, i, G, c, u); }
    __device__ __forceinline__ int ntiles(const Unit&) const { return K / 128; }
    __device__ __forceinline__ void setup(const Unit& u, int tid, g8::Rsrc& ra, g8::Rsrc& rb, int& db, unsigned (&o)[1], unsigned& vb, int& a64, int& b64) const {
        vb = g8::voff_b(tid, LDBB); a64 = 64 * LDAB; b64 = 64 * LDBB;
        ra = g8::mk_rsrc((const char*)ACT + (size_t)(u.base + u.rt * 256) * DFF);
        { int tz = tid; asm volatile("" : "+v"(tz)); int R, C; g8::stage_rc(tz * 16, R, C); o[0] = (unsigned)(R * DFF + C * 2); }
        rb = g8::mk_rsrc((const char*)W2 + ((size_t)u.e * DM + u.ct * 256) * DFF); db = 128 * DFF;
    }
    __device__ __forceinline__ void epi(Acc& acc, const Unit& u, int wr, int wc, int fr, int fq) const {
        if (STUB) { f32x4 t = {0.f, 0.f, 0.f, 0.f};
#pragma unroll
            for (int a_ = 0; a_ < 2; ++a_)
#pragma unroll
                for (int b_ = 0; b_ < 2; ++b_)
#pragma unroll
                    for (int m_ = 0; m_ < 4; ++m_)
#pragma unroll
                        for (int n_ = 0; n_ < 2; ++n_) t += acc[a_][b_][m_][n_];
            if (t[0] + t[1] + t[2] + t[3] == 1.2345e30f) YB[0] = 1; return; }
        const int col0 = u.ct * 256 + wc * 32 + 8 * fq; const float* bb = b2 + (size_t)u.e * DM;
        f32x4 bv[2][2];
#pragma unroll
        for (int bj = 0; bj < 2; ++bj) { bv[bj][0] = ld4(bb + col0 + bj * 128); bv[bj][1] = ld4(bb + col0 + bj * 128 + 4); }
        const int* el = elist + (size_t)u.e * NTOK;
#pragma unroll
        for (int ai = 0; ai < 2; ++ai) {
            int slot[4]; float wv[4];
#pragma unroll
            for (int q = 0; q < 4; ++q) { const int pos = u.rt * 256 + ai * 128 + wr * 64 + q * 16 + fr; slot[q] = el[pos < u.cnt ? pos : 0] & 0xffff; }
#pragma unroll
            for (int q = 0; q < 4; ++q) { const int pos = u.rt * 256 + ai * 128 + wr * 64 + q * 16 + fr; wv[q] = pw[(size_t)u.e * NTOK + (pos < u.cnt ? pos : 0)] * YB8_SCALE; }
#pragma unroll
            for (int m = 0; m < 4; ++m) {
                const int pos = u.rt * 256 + ai * 128 + wr * 64 + m * 16 + fr; const float w = wv[m]; const int sl = slot[m];
                if (pos < u.cnt) {
#pragma unroll
                    for (int bj = 0; bj < 2; ++bj)
                        st8(YB + (size_t)sl * DM + col0 + bj * 128, pack8_fp8((acc[ai][bj][m][0] * (1.0f / (W8_SCALE * ACT8_SCALE)) + bv[bj][0]) * w, (acc[ai][bj][m][1] * (1.0f / (W8_SCALE * ACT8_SCALE)) + bv[bj][1]) * w));
                }
            }
        }
    }
};
typedef ProbMoe2T<0> ProbMoe2;

struct ProbPle : g8::DenseBase<PLE, PLE, PLE> {
    bf16_t* PE;
    __device__ __forceinline__ void epi(Acc& acc, const Unit& u, int wr, int wc, int fr, int fq) const {
        const int row0 = u.pm * 256 + wr * 64 + fr, col0 = u.pn * 256 + wc * 32 + 8 * fq;
#pragma unroll
        for (int ai = 0; ai < 2; ++ai)
#pragma unroll
            for (int m = 0; m < 4; ++m)
#pragma unroll
                for (int bj = 0; bj < 2; ++bj) st16(PE + (size_t)(row0 + ai * 128 + m * 16) * DM + col0 + bj * 128, pack8(acc[ai][bj][m][0], acc[ai][bj][m][1]));
    }
};
struct ProbGate8 {
    static constexpr bool FP8 = true, GATHER = false;
    typedef g8::Unit2 Unit;
    g8::StaticOrder S; const unsigned char *H2Q, *WPG8; const bf16_t *H2B, *PE; const float* rstd3; bf16_t* H3B; float* SS3;
    __device__ __forceinline__ bool next(int i, Unit& u) const { return S.next(i, u); }
    __device__ __forceinline__ bool keep_acc(const Unit&) const { return false; }
    __device__ __forceinline__ int ntiles(const Unit&) const { return DM / 128; }
    __device__ __forceinline__ void setup(const Unit& u, int tid, g8::Rsrc& ra, g8::Rsrc& rb, int& db, unsigned (&o)[1], unsigned& vb, int& a64, int& b64) const {
        vb = g8::voff_b(tid, DM); a64 = 64 * DM; b64 = 64 * DM;
        ra = g8::mk_rsrc((const char*)H2Q + (size_t)u.pm * 256 * DM);
        { int tz = tid; asm volatile("" : "+v"(tz)); int R, C; g8::stage_rc(tz * 16, R, C); o[0] = (unsigned)(R * DM + C * 2); }
        rb = g8::mk_rsrc((const char*)WPG8 + (size_t)u.pn * 256 * DM); db = 128 * DM;
    }
    __device__ __forceinline__ void epi(Acc& acc, const Unit& u, int wr, int wc, int fr, int fq) const {
        const int row0 = u.pm * 256 + wr * 64 + fr, col0 = u.pn * 256 + wc * 32 + 8 * fq;
        float rsv[8];
#pragma unroll
        for (int q = 0; q < 8; ++q) rsv[q] = rstd3[row0 + (q >> 2) * 128 + (q & 3) * 16] * (1.0f / W8_SCALE);
        u32x4 pn[2], hn[2];
#pragma unroll
        for (int bj = 0; bj < 2; ++bj) { const size_t o = (size_t)row0 * DM + col0 + bj * 128; pn[bj] = ld16(PE + o); hn[bj] = ld16(H2B + o); }
#pragma unroll
        for (int q = 0; q < 8; ++q) {
            const int ai = q >> 2, m = q & 3; const int row = row0 + ai * 128 + m * 16; const float rs = rsv[q];
            u32x4 pc[2], hc[2];
#pragma unroll
            for (int t = 0; t < 2; ++t) { pc[t] = pn[t]; hc[t] = hn[t]; }
            if (q < 7) { const int rn = row0 + ((q + 1) >> 2) * 128 + ((q + 1) & 3) * 16;
#pragma unroll
                for (int bj = 0; bj < 2; ++bj) { const size_t o = (size_t)rn * DM + col0 + bj * 128; pn[bj] = ld16(PE + o); hn[bj] = ld16(H2B + o); } }
            float ss = 0.f;
#pragma unroll
            for (int bj = 0; bj < 2; ++bj) {
                const size_t o = (size_t)row * DM + col0 + bj * 128;
                f32x4 pe[2], h[2], v[2]; unpack8(pc[bj], pe[0], pe[1]); unpack8(hc[bj], h[0], h[1]);
#pragma unroll
                for (int n = 0; n < 2; ++n)
#pragma unroll
                    for (int j = 0; j < 4; ++j) { v[n][j] = h[n][j] + fsigmoid(acc[ai][bj][m][n][j] * rs) * pe[n][j]; ss += v[n][j] * v[n][j]; }
                st16(H3B + o, pack8(v[0], v[1]));
            }
            ss += __shfl_xor(ss, 16); ss += __shfl_xor(ss, 32);
            if (fq == 0) SS3[(size_t)row * 32 + u.pn * 4 + wc] = ss;
        }
    }
};

__device__ __forceinline__ void tr_item(const float* W, int N, bf16_t* WT, int K, const float* scale, int kb, int nb, LAS float* scr, int lane) {
    const int k0 = kb * 64, n0 = nb * 64, lr = lane >> 4, lc = (lane & 15) * 4;
    f32x4 v[16];
#pragma unroll
    for (int i = 0; i < 16; ++i) v[i] = __builtin_nontemporal_load((const GAS f32x4*)(W + (size_t)(k0 + 4 * i + lr) * N + n0 + lc));
#pragma unroll
    for (int i = 0; i < 16; ++i) { const int kk = 4 * i + lr; const float sc = scale ? scale[k0 + kk] : 1.0f;
        scr[kk * 65 + lc + 0] = v[i][0] * sc; scr[kk * 65 + lc + 1] = v[i][1] * sc; scr[kk * 65 + lc + 2] = v[i][2] * sc; scr[kk * 65 + lc + 3] = v[i][3] * sc; }
    LDS_WAIT();
    const int c = lane & 7;
#pragma unroll
    for (int j = 0; j < 8; ++j) { const int n = (lane >> 3) + 8 * j; const LAS float* s = scr + (8 * c) * 65 + n;
        u32x4 o; o.x = pk2(s[0 * 65], s[1 * 65]); o.y = pk2(s[2 * 65], s[3 * 65]); o.z = pk2(s[4 * 65], s[5 * 65]); o.w = pk2(s[6 * 65], s[7 * 65]);
        st16(WT + (size_t)(n0 + n) * K + k0 + 8 * c, o); }
    LDS_WAIT();
}

struct TrJob { const float* W; unsigned char* WQ; const float* scale; int N, K, kb, nb; };
struct TrRegs { f32x4 v[16]; float sc[16]; };
__device__ __forceinline__ void tr8_load(const TrJob& j, TrRegs& r, float mul, int lane) {
    const int k0 = j.kb * 128, n0 = j.nb * 32, lr = lane >> 3, lc = (lane & 7) * 4;
#pragma unroll
    for (int i = 0; i < 16; ++i) r.sc[i] = j.scale ? j.scale[k0 + 8 * i + lr] * mul : mul;
#pragma unroll
#ifdef CONV_PLAIN_LD
    for (int i = 0; i < 16; ++i) r.v[i] = *(const GAS f32x4*)(j.W + (size_t)(k0 + 8 * i + lr) * j.N + n0 + lc);
#else
    for (int i = 0; i < 16; ++i) r.v[i] = __builtin_nontemporal_load((const GAS f32x4*)(j.W + (size_t)(k0 + 8 * i + lr) * j.N + n0 + lc));
#endif
}
__device__ __forceinline__ void tr8_finish(const TrJob& j, const TrRegs& r, LAS float* scr, int lane) {
    const int k0 = j.kb * 128, n0 = j.nb * 32, lr = lane >> 3, lc = (lane & 7) * 4;
#pragma unroll
    for (int i = 0; i < 16; ++i) { const int kk = 8 * i + lr; const f32x4 t = r.v[i] * r.sc[i];
        scr[(lc + 0) * 130 + kk] = t[0]; scr[(lc + 1) * 130 + kk] = t[1]; scr[(lc + 2) * 130 + kk] = t[2]; scr[(lc + 3) * 130 + kk] = t[3]; }
    LDS_WAIT();
    const int c = lane & 7;
#pragma unroll
    for (int jj = 0; jj < 4; ++jj) { const int n = (lane >> 3) + 8 * jj; const LAS f32x2* sp = (const LAS f32x2*)(scr + n * 130 + 16 * c);
        u32x4 o;
#pragma unroll
        for (int q = 0; q < 4; ++q) { const f32x2 p0 = sp[2 * q], p1 = sp[2 * q + 1]; int w = 0; w = __builtin_amdgcn_cvt_pk_fp8_f32(p0[0], p0[1], w, false); w = __builtin_amdgcn_cvt_pk_fp8_f32(p1[0], p1[1], w, true); o[q] = (unsigned)w; }
        __builtin_nontemporal_store(o, (GAS u32x4*)(j.WQ + (size_t)(n0 + n) * j.K + k0 + 16 * c)); }
    LDS_WAIT();
}
constexpr int I_W1 = 32 * 16 * 128, I_W2 = 32 * 16 * 64, I_MOE = I_W1 + I_W2;
__device__ __forceinline__ TrJob moe_job(const float* w1, const float* w2, const float* gffn, unsigned char* ws, int it) {
    TrJob j;
    if (it < I_W1) { const int e = it >> 11, q = it & 2047; j.W = w1 + (size_t)e * DM * 2 * DFF; j.N = 2 * DFF; j.WQ = ws + WS_W1 + (size_t)e * 2 * DFF * DM; j.K = DM; j.scale = gffn; j.kb = q >> 7; j.nb = q & 127; }
    else { const int r = it - I_W1, e = r >> 10, q = r & 1023; j.W = w2 + (size_t)e * DFF * DM; j.N = DM; j.WQ = ws + WS_W2 + (size_t)e * DM * DFF; j.K = DFF; j.scale = nullptr; j.kb = q >> 6; j.nb = q & 63; }
    return j;
}
constexpr int NB_W1 = 32 * 16 * 32, NB_W2 = 32 * 16 * 16, NB_MOE = NB_W1 + NB_W2;
struct BlkJob { const float* W; unsigned char* WQ; const float* scale; int N, K, kb, nb, use_scale; };
constexpr int NB_PG = 16 * 16, NB_ALL = NB_MOE + 3 * NB_PG, NB_IN8 = 16 * ((INW - PN8_FIRST * 256) / 128);
__device__ __forceinline__ BlkJob moe_blk(const float* w1, const float* w2, const float* gffn, unsigned char* ws, int it, const float* wpg, const float* gple, const float* win, const float* gmix, const float* wap, const float* wlp) {
    BlkJob j;
    if (it >= NB_ALL) { const int q = it - NB_ALL; constexpr int NNB = (INW - PN8_FIRST * 256) / 128; j.W = win + PN8_FIRST * 256; j.N = INW; j.WQ = ws + WS_WIN8; j.K = DM; j.scale = gmix; j.use_scale = 1; j.kb = q / NNB; j.nb = q % NNB; }
    else if (it >= NB_MOE + 2 * NB_PG) { const int q = it - NB_MOE - 2 * NB_PG; j.W = wlp; j.N = DM; j.WQ = ws + WS_WLP; j.K = DM; j.scale = gple; j.use_scale = 0; j.kb = q >> 4; j.nb = q & 15; }
    else if (it >= NB_MOE + NB_PG) { const int q = it - NB_MOE - NB_PG; j.W = wap; j.N = DM; j.WQ = ws + WS_WAP; j.K = DM; j.scale = gple; j.use_scale = 0; j.kb = q >> 4; j.nb = q & 15; }
    else if (it >= NB_MOE) { const int q = it - NB_MOE; j.W = wpg; j.N = DM; j.WQ = ws + WS_WPG; j.K = DM; j.scale = gple; j.use_scale = 1; j.kb = q >> 4; j.nb = q & 15; }
    else if (it < NB_W1) { const int e = it >> 9, q = it & 511; j.W = w1 + (size_t)e * DM * 2 * DFF; j.N = 2 * DFF; j.WQ = ws + WS_W1 + (size_t)e * 2 * DFF * DM; j.K = DM; j.scale = gffn; j.use_scale = 1; j.kb = q >> 5; j.nb = q & 31; }
    else { const int r = it - NB_W1, e = r >> 8, q = r & 255; j.W = w2 + (size_t)e * DFF * DM; j.N = DM; j.WQ = ws + WS_W2 + (size_t)e * DM * DFF; j.K = DFF; j.scale = gffn; j.use_scale = 0; j.kb = q >> 4; j.nb = q & 15; }
    return j;
}
__device__ __forceinline__ void blk_load(const BlkJob& j, f32x4 (&v)[8], float (&sc)[8], int wave, int lane) {
    const int kr = 16 * wave + (lane >> 5), g = lane & 31;
#pragma unroll
    for (int i = 0; i < 8; ++i) { const float g = j.scale[j.kb * 128 + kr + 2 * i]; sc[i] = (j.use_scale ? g : 1.0f) * W8_SCALE; }
#pragma unroll
    for (int i = 0; i < 8; ++i) v[i] = __builtin_nontemporal_load((const GAS f32x4*)(j.W + (size_t)(j.kb * 128 + kr + 2 * i) * j.N + j.nb * 128 + 4 * g));
}
__device__ __forceinline__ void blk_put(const f32x4 (&v)[8], const float (&sc)[8], LAS float* buf, int wave, int lane) {
    const int kr = 16 * wave + (lane >> 5), g = lane & 31;
#pragma unroll
    for (int i = 0; i < 8; ++i) { const int k = kr + 2 * i; *(LAS f32x4*)(buf + k * 128 + 4 * (g ^ (k >> 4))) = v[i] * sc[i]; }
}
__device__ __forceinline__ void blk_emit(const BlkJob& cur, const LAS float* buf, int wave, int lane) {
    const int c = lane & 7;
#pragma unroll
    for (int jj = 0; jj < 2; ++jj) { const int nn = 16 * wave + (lane >> 3) + 8 * jj; const LAS float* sp = buf + (16 * c) * 128 + 4 * ((nn >> 2) ^ c) + (nn & 3);
        u32x4 o;
#pragma unroll
        for (int q = 0; q < 4; ++q) { int w = 0; w = __builtin_amdgcn_cvt_pk_fp8_f32(sp[(4 * q) * 128], sp[(4 * q + 1) * 128], w, false); w = __builtin_amdgcn_cvt_pk_fp8_f32(sp[(4 * q + 2) * 128], sp[(4 * q + 3) * 128], w, true); o[q] = (unsigned)w; }
        __builtin_nontemporal_store(o, (GAS u32x4*)(cur.WQ + (size_t)(cur.nb * 128 + nn) * cur.K + cur.kb * 128 + 16 * c)); }
}
__device__ __forceinline__ void moe_convert_blocks(const float* w1, const float* w2, const float* gffn, unsigned char* ws, int it0, int n, LAS unsigned char* lds, int wave, int lane, const float* wpg, const float* gple, const float* win, const float* gmix, const float* wap, const float* wlp) {
    if (n <= 0) return;
    const int itl = it0 + n - 1;
    BlkJob j0 = moe_blk(w1, w2, gffn, ws, it0, wpg, gple, win, gmix, wap, wlp), j1 = moe_blk(w1, w2, gffn, ws, it0 + 1 < itl ? it0 + 1 : itl, wpg, gple, win, gmix, wap, wlp);
    f32x4 v0[8], v1[8]; float s0[8], s1[8];
    blk_load(j0, v0, s0, wave, lane);
    blk_load(j1, v1, s1, wave, lane);
    LAS float* bufA = (LAS float*)lds; LAS float* bufB = (LAS float*)(lds + 65536);
#pragma unroll 1
    for (int b = 0; b < n; b += 2) {
        blk_put(v0, s0, bufA, wave, lane);
        __syncthreads();
        const BlkJob c0 = j0;
        { const int t = it0 + b + 2; j0 = moe_blk(w1, w2, gffn, ws, t < itl ? t : itl, wpg, gple, win, gmix, wap, wlp); blk_load(j0, v0, s0, wave, lane); }
        blk_emit(c0, bufA, wave, lane);
        blk_put(v1, s1, bufB, wave, lane);
        __syncthreads();
        const BlkJob c1 = j1;
        { const int t = it0 + b + 3; j1 = moe_blk(w1, w2, gffn, ws, t < itl ? t : itl, wpg, gple, win, gmix, wap, wlp); blk_load(j1, v1, s1, wave, lane); }
        blk_emit(c1, bufB, wave, lane);
    }
    __syncthreads();
}

struct Args { const float* in[27]; float* out; unsigned char* ws; int ph_lo, ph_hi; };

__device__ __forceinline__ void p0_prologue(const Args& a, LAS unsigned char* lds, int gw, int NGW, int lane, int wave) {
    unsigned char* ws = a.ws;
    LAS float* scr = (LAS float*)(lds + wave * 16896);
    constexpr int NB64 = PN8_FIRST * 4, I_IN = 32 * NB64, I_SQ = 32 * 32, I_PLE = 4 * 32, I_RG = 8 * 16, dummy_ = 0;
    constexpr int NIT = I_IN + 1 * I_SQ + I_PLE + 2 * I_RG; (void)dummy_;
    for (int it = gw; it < NIT; it += NGW) {
        int r = it;
        if (NB64 > 0 && r < I_IN) { const int nb64 = NB64 > 0 ? NB64 : 1; tr_item(a.in[3], INW, (bf16_t*)(ws + WS_WIN), DM, a.in[2], r / nb64, r % nb64, scr, lane); continue; } r -= I_IN;
        if (r < I_SQ) { tr_item(a.in[15], DM, (bf16_t*)(ws + WS_WOUT), DM, nullptr, r / 32, r % 32, scr, lane); continue; } r -= I_SQ;
        if (r < I_PLE) { tr_item(a.in[24], DM, (bf16_t*)(ws + WS_WPLE), PLE, nullptr, r / 32, r % 32, scr, lane); continue; } r -= I_PLE;
        if (r < I_RG) { const int mtx = r >> 4, q = r & 15; tr_item(a.in[7] + (size_t)mtx * 65536, 256, (bf16_t*)(ws + WS_WRG) + (size_t)mtx * 65536, 256, nullptr, q >> 2, q & 3, scr, lane); continue; } r -= I_RG;
        { const int mtx = r >> 4, q = r & 15; tr_item(a.in[9] + (size_t)mtx * 65536, 256, (bf16_t*)(ws + WS_WRG) + (size_t)(8 + mtx) * 65536, 256, nullptr, q >> 2, q & 3, scr, lane); }
    }
    __syncthreads();
    { const int G = NGW / NWAVES, bxx = gw / NWAVES;
      const int per = (NB_IN8 + G - 1) / G, b0 = bxx * per; int n = per; if (b0 + n > NB_IN8) n = NB_IN8 - b0;
      moe_convert_blocks(a.in[19], a.in[21], a.in[16], ws, NB_ALL + b0, n, lds, wave, lane, a.in[25], a.in[23], a.in[3], a.in[2], a.in[13], a.in[14]); }
    const float* x = a.in[0]; bf16_t* XB = (bf16_t*)(ws + WS_XB); float* rstd1 = (float*)(ws + WS_RSTD1); unsigned char* XQ = ws + WS_H1Q;
    for (int m = gw; m < NTOK; m += NGW) {
        float ss = 0.f;
#pragma unroll
        for (int j = 0; j < 4; ++j) { const size_t o = (size_t)m * DM + j * 512 + lane * 8; const f32x4 v0 = ld4(x + o), v1 = ld4(x + o + 4);
            ss += (v0[0] * v0[0] + v0[1] * v0[1]) + (v0[2] * v0[2] + v0[3] * v0[3]) + (v1[0] * v1[0] + v1[1] * v1[1]) + (v1[2] * v1[2] + v1[3] * v1[3]);
            if (PN8_FIRST > 0) st16(XB + o, pack8(v0, v1));
            st8(XQ + o, pack8_fp8(v0 * X8_SCALE, v1 * X8_SCALE)); }
        ss = wave_sum(ss);
        if (lane == 0) rstd1[m] = 1.0f / sqrtf(ss * (1.0f / DM) + RMS_EPS);
    }
    const float* p = a.in[1]; bf16_t* PB = (bf16_t*)(ws + WS_PB);
    for (int i = gw * 64 + lane; i < NTOK * PLE / 8; i += NGW * 64) { const size_t o = (size_t)i * 8; st16(PB + o, pack8(ld4(p + o), ld4(p + o + 4))); }
    bf16_t* WRH = (bf16_t*)(ws + WS_WR); bf16_t* WRL = WRH + NEXP * DM;
    for (int i = gw * 64 + lane; i < NEXP * DM; i += NGW * 64) { const int e = i >> 11, k = i & 2047; const float v = a.in[17][(size_t)k * NEXP + e] * a.in[16][k];
        const unsigned h = pk2(v, 0.f) & 0xffffu; const float r = v - __uint_as_float(h << 16); WRH[i] = (bf16_t)h; WRL[i] = (bf16_t)(pk2(r, 0.f) & 0xffffu); }
}

constexpr int KS_PITCH = 80, VS_PITCH = 80, VS_OFF = 256 * KS_PITCH * 2;
typedef short v4i16_t __attribute__((ext_vector_type(4)));
__device__ __forceinline__ u32x2 vtr(const LAS bf16_t* p) { return __builtin_bit_cast(u32x2, __builtin_amdgcn_ds_read_tr16_b64_v4i16((LAS v4i16_t*)p)); }
template <bool ODD>
__device__ __forceinline__ void attn_qg(const LAS bf16_t* Ks, const LAS bf16_t* Vt, const bf16x8 q0, const bf16x8 q1, bf16_t* YA, int m_cur, int nbi, int h, float sink2, int fr, int fq, int dmask, int qg) {
    constexpr int WSKIP = ODD ? 0 : 9, WD = ODD ? 1 : 0, WU = ODD ? 9 : 8;
    f32x4 s[10];
    const int kt0 = qg - (ODD ? 1 : 0);
    int koff = fr * KS_PITCH + fq * 8 + kt0 * 16 * KS_PITCH, voff = (kt0 * 16 + 4 * fq + (fr >> 2)) * VS_PITCH + 4 * (fr & 3);
    asm volatile("" : "+v"(koff), "+v"(voff));
#pragma unroll
    for (int w = 0; w < 10; ++w) {
        if (w == WSKIP) { s[w] = (f32x4){0.f, 0.f, 0.f, 0.f}; continue; }
        const bf16x8 k0 = *(const LAS bf16x8*)(Ks + koff + w * 16 * KS_PITCH), k1 = *(const LAS bf16x8*)(Ks + koff + w * 16 * KS_PITCH + 32);
        f32x4 z = (f32x4){0.f, 0.f, 0.f, 0.f};
        z = __builtin_amdgcn_mfma_f32_16x16x32_bf16(k0, q0, z, 0, 0, 0);
        s[w] = __builtin_amdgcn_mfma_f32_16x16x32_bf16(k1, q1, z, 0, 0, 0);
    }
#pragma unroll
    for (int r = 0; r < 4; ++r) { const bool d = (dmask >> r) & 1; s[WD][r] = d ? s[WD][r] : -3.0e38f; s[WU][r] = d ? -3.0e38f : s[WU][r]; }
    if (nbi == 0) {
#pragma unroll
        for (int w = 0; w < 10; ++w)
#pragma unroll
            for (int r = 0; r < 4; ++r) if (w != WSKIP) s[w][r] = ((kt0 + w) * 16 + 4 * fq + r >= 128) ? s[w][r] : -3.0e38f;
    }
    float mx = sink2;
#pragma unroll
    for (int w = 0; w < 10; ++w) if (w != WSKIP) mx = fmaxf(fmaxf(mx, fmaxf(s[w][0], s[w][1])), fmaxf(s[w][2], s[w][3]));
    mx = fmaxf(mx, __shfl_xor(mx, 16)); mx = fmaxf(mx, __shfl_xor(mx, 32));
    float sum = 0.f;
#pragma unroll
    for (int w = 0; w < 10; ++w)
#pragma unroll
        for (int r = 0; r < 4; ++r) if (w != WSKIP) { const float pv = __builtin_amdgcn_exp2f(s[w][r] - mx); s[w][r] = pv; sum += pv; }
    sum += __shfl_xor(sum, 16); sum += __shfl_xor(sum, 32);
    sum += __builtin_amdgcn_exp2f(sink2 - mx);
    const float inv = __builtin_amdgcn_rcpf(sum);
    f32x4 o[4];
#pragma unroll
    for (int dt = 0; dt < 4; ++dt) o[dt] = (f32x4){0.f, 0.f, 0.f, 0.f};
#pragma unroll
    for (int i2 = 0; i2 < 5; ++i2) {
        union { u32x4 u; bf16x8 v; } pf; pf.u = pack8(s[2 * i2], s[2 * i2 + 1]);
#pragma unroll
        for (int dt = 0; dt < 4; ++dt) {
            const LAS bf16_t* vr = Vt + voff + dt * 16 + 32 * i2 * VS_PITCH;
            union { struct { u32x2 lo, hi; } h2; bf16x8 v; } vf; vf.h2.lo = vtr(vr); vf.h2.hi = vtr(vr + 16 * VS_PITCH);
            o[dt] = __builtin_amdgcn_mfma_f32_16x16x32_bf16(vf.v, pf.v, o[dt], 0, 0, 0);
        }
    }
    unsigned char* yo = (unsigned char*)YA + (size_t)(m_cur + qg * 16 + fr) * DM + h * 64 + 4 * fq; const float inv8 = inv * Y8_SCALE;
#pragma unroll
    for (int dt = 0; dt < 4; ++dt) { int w = 0; w = __builtin_amdgcn_cvt_pk_fp8_f32(o[dt][0] * inv8, o[dt][1] * inv8, w, false); w = __builtin_amdgcn_cvt_pk_fp8_f32(o[dt][2] * inv8, o[dt][3] * inv8, w, true); *(GAS unsigned*)(yo + dt * 16) = (unsigned)w; }
}

__device__ __forceinline__ void attn_unit(LAS unsigned char* lds, const bf16_t* Z, const float* sinks, bf16_t* YA, int unit, int tid) {
    const int b = unit >> 7, nbi = (unit >> 2) & 31, kvh = unit & 3;
    const int m_cur = b * SEQ + nbi * 128;
    LAS bf16_t* Ks = (LAS bf16_t*)lds; LAS bf16_t* Vt = (LAS bf16_t*)(lds + VS_OFF);
    const int wid = tid >> 6, lane = tid & 63, fr = lane & 15, fq = lane >> 4;
    const int h = kvh * 8 + wid;
    const bf16_t* qbase = Z + (size_t)(m_cur + fr) * INW + COL_Q + h * 64 + fq * 8;
    bf16x8 qn0 = *(const GAS bf16x8*)(qbase), qn1 = *(const GAS bf16x8*)(qbase + 32), qn2 = *(const GAS bf16x8*)(qbase + 16 * INW), qn3 = *(const GAS bf16x8*)(qbase + 16 * INW + 32);
    u32x4 kv[4], vv[4];
#pragma unroll
    for (int i = 0; i < 4; ++i) {
        const int c = tid + 512 * i, j = c >> 3, c8 = c & 7; const bool valid = (nbi > 0) || (j >= 128);
        const size_t ro = (size_t)(valid ? m_cur - 128 + j : m_cur) * INW;
        kv[i] = ld16(Z + ro + COL_K + kvh * 64 + c8 * 8); vv[i] = ld16(Z + ro + COL_V + kvh * 64 + c8 * 8);
    }
#pragma unroll
    for (int i = 0; i < 4; ++i) {
        const int c = tid + 512 * i, j = c >> 3, c8 = c & 7;
        *(LAS u32x4*)(Ks + j * KS_PITCH + c8 * 8) = kv[i];
        *(LAS u32x4*)(Vt + j * VS_PITCH + c8 * 8) = vv[i];
    }
    __syncthreads();
    const float sink = sinks[h];
    const float sink2 = sink * 1.4426950409f;
    const int dmask = ((4 * fq + 0 > fr) ? 1 : 0) | ((4 * fq + 1 > fr) ? 2 : 0) | ((4 * fq + 2 > fr) ? 4 : 0) | ((4 * fq + 3 > fr) ? 8 : 0);
    __builtin_amdgcn_s_waitcnt(0x0F70);
#pragma unroll 1
    for (int qp = 0; qp < 4; ++qp) {
        const bf16x8 qc0 = qn0, qc1 = qn1, qc2 = qn2, qc3 = qn3;
        const bf16_t* qnx = qbase + (size_t)(qp < 3 ? 32 * (qp + 1) : 96) * INW;
        qn0 = *(const GAS bf16x8*)(qnx); qn1 = *(const GAS bf16x8*)(qnx + 32); qn2 = *(const GAS bf16x8*)(qnx + 16 * INW); qn3 = *(const GAS bf16x8*)(qnx + 16 * INW + 32);
        attn_qg<false>(Ks, Vt, qc0, qc1, YA, m_cur, nbi, h, sink2, fr, fq, dmask, 2 * qp);
        attn_qg<true>(Ks, Vt, qc2, qc3, YA, m_cur, nbi, h, sink2, fr, fq, dmask, 2 * qp + 1);
    }
    __syncthreads();
}

__device__ __forceinline__ void conv_items(const bf16_t* Z, const float* cw, const float* cb, bf16_t* UC, int gw, int NGW, int lane) {
    for (int it = gw; it < 2048; it += NGW) {
        const int cblk = it & 3, tch = it >> 2, c8 = cblk * 512 + lane * 8, m0 = tch * 32;
        f32x4 w0[4], w1[4];
#pragma unroll
        for (int tap = 0; tap < 4; ++tap) { w0[tap] = ld4(cw + tap * DM + c8); w1[tap] = ld4(cw + tap * DM + c8 + 4); }
        const f32x4 b0 = ld4(cb + c8), b1 = ld4(cb + c8 + 4);
        const bf16_t* zp = Z + (size_t)m0 * INW + COL_U + c8;
        u32x4 h[3];
#pragma unroll
        for (int q = 0; q < 3; ++q) h[q] = ((m0 & (SEQ - 1)) == 0) ? (u32x4){0u, 0u, 0u, 0u} : ld16(zp - (size_t)(3 - q) * INW);
#pragma unroll 1
        for (int t0 = 0; t0 < 32; t0 += 8) {
            u32x4 r[8];
#pragma unroll
            for (int j = 0; j < 8; ++j) r[j] = ld16(zp + (size_t)(t0 + j) * INW);
#pragma unroll
            for (int j = 0; j < 8; ++j) {
                f32x4 a0 = b0, a1 = b1, u0, u1;
                unpack8(h[0], u0, u1); a0 += u0 * w0[0]; a1 += u1 * w1[0];
                unpack8(h[1], u0, u1); a0 += u0 * w0[1]; a1 += u1 * w1[1];
                unpack8(h[2], u0, u1); a0 += u0 * w0[2]; a1 += u1 * w1[2];
                unpack8(r[j], u0, u1); a0 += u0 * w0[3]; a1 += u1 * w1[3];
                st16(UC + (size_t)(m0 + t0 + j) * DM + c8, pack8(a0, a1));
                h[0] = h[1]; h[1] = h[2]; h[2] = r[j];
            }
        }
    }
}

constexpr int SC_PITCH = 72;
__device__ __forceinline__ void scan_unit(LAS unsigned char* lds, const bf16_t* LA2, const bf16_t* XIN, const bf16_t* GG, bf16_t* YL, int unit, int tid) {
    const int b = unit >> 6, cg = unit & 63, pair = tid & 15, sub = tid >> 4;
    const size_t base = (size_t)unit * SEQ * 32;
    LAS unsigned char* sA = lds; LAS unsigned char* sX = lds + 256 * SC_PITCH; LAS unsigned char* sG = lds + 2 * 256 * SC_PITCH;
    LAS float* sP = (LAS float*)(lds + 3 * 256 * SC_PITCH); LAS float* sH = sP + 1024; LAS float* sC = sH + 1024;
    if (tid < 32) sC[tid] = 0.f;
    u32x4 ra[2], rx[2], rg[2];
#pragma unroll
    for (int i = 0; i < 2; ++i) { const size_t o = base + (size_t)(tid + 512 * i) * 8; ra[i] = ld16(LA2 + o); rx[i] = ld16(XIN + o); rg[i] = ld16(GG + o); }
#pragma unroll 1
    for (int c = 0; c < 16; ++c) {
#pragma unroll
        for (int i = 0; i < 2; ++i) { const int q = tid + 512 * i, off = (q >> 2) * SC_PITCH + (q & 3) * 16;
            *(LAS u32x2*)(sA + off) = (u32x2){ra[i].x, ra[i].y}; *(LAS u32x2*)(sA + off + 8) = (u32x2){ra[i].z, ra[i].w};
            *(LAS u32x2*)(sX + off) = (u32x2){rx[i].x, rx[i].y}; *(LAS u32x2*)(sX + off + 8) = (u32x2){rx[i].z, rx[i].w};
            *(LAS u32x2*)(sG + off) = (u32x2){rg[i].x, rg[i].y}; *(LAS u32x2*)(sG + off + 8) = (u32x2){rg[i].z, rg[i].w}; }
        __syncthreads();
        if (c < 15) {
#pragma unroll
            for (int i = 0; i < 2; ++i) { const size_t o = base + (size_t)(c + 1) * 8192 + (size_t)(tid + 512 * i) * 8; ra[i] = ld16(LA2 + o); rx[i] = ld16(XIN + o); rg[i] = ld16(GG + o); }
        }
        float a0[8], a1[8], x0[8], x1[8]; float P0 = 1.f, P1 = 1.f, H0 = 0.f, H1 = 0.f;
        const int lo = (sub * 8) * SC_PITCH + pair * 4;
#pragma unroll
        for (int j = 0; j < 8; ++j) { const unsigned la = *(const LAS unsigned*)(sA + lo + j * SC_PITCH), xx = *(const LAS unsigned*)(sX + lo + j * SC_PITCH);
            a0[j] = __builtin_amdgcn_exp2f(bflo(la)); a1[j] = __builtin_amdgcn_exp2f(bfhi(la)); x0[j] = bflo(xx); x1[j] = bfhi(xx);
            H0 = a0[j] * H0 + x0[j]; P0 *= a0[j]; H1 = a1[j] * H1 + x1[j]; P1 *= a1[j]; }
        sP[sub * 32 + 2 * pair] = P0; sP[sub * 32 + 2 * pair + 1] = P1; sH[sub * 32 + 2 * pair] = H0; sH[sub * 32 + 2 * pair + 1] = H1;
        __syncthreads();
        float h0 = sC[2 * pair], h1 = sC[2 * pair + 1];
#pragma unroll 1
        for (int sI = 0; sI < sub; ++sI) { h0 = sP[sI * 32 + 2 * pair] * h0 + sH[sI * 32 + 2 * pair]; h1 = sP[sI * 32 + 2 * pair + 1] * h1 + sH[sI * 32 + 2 * pair + 1]; }
        unsigned char* yo = (unsigned char*)YL + (size_t)(b * SEQ + c * 256 + sub * 8) * DM + cg * 32 + 2 * pair;
#pragma unroll
        for (int j = 0; j < 8; ++j) { h0 = a0[j] * h0 + x0[j]; h1 = a1[j] * h1 + x1[j]; const unsigned g = *(const LAS unsigned*)(sG + lo + j * SC_PITCH);
            const float y0 = __builtin_amdgcn_fmed3f(h0 * bflo(g) * Y8_SCALE, -448.0f, 448.0f), y1 = __builtin_amdgcn_fmed3f(h1 * bfhi(g) * Y8_SCALE, -448.0f, 448.0f);
            *(GAS unsigned short*)(yo + (size_t)j * DM) = (unsigned short)__builtin_amdgcn_cvt_pk_fp8_f32(y0, y1, 0, false); }
        __syncthreads();
        if (sub == 31) { sC[2 * pair] = h0; sC[2 * pair + 1] = h1; }
    }
    __syncthreads();
}

__device__ __forceinline__ void router_unit(LAS unsigned char* lds, const float* H1, const bf16_t* WRH, const bf16_t* WRL, const float* b_r,
                                            float* topw, float* rstd2, int* elist, float* prs, float* pw, unsigned* ecnt, int unit, int tid) {
    const int wid = tid >> 6, lane = tid & 63, rg = wid >> 2, kq = wid & 3;
    LAS float* part = (LAS float*)lds;
    LAS float* ssp = part + 8 * 32 * 33;
    LAS float* lg = ssp + 256;
    LAS int* lcnt = (LAS int*)(lg + 64 * 33);
    LAS int* gbase = lcnt + 32;
    LAS float* lrs = (LAS float*)(gbase + 32);
    const int row0 = unit * 64;
    if (tid < 32) lcnt[tid] = 0;
    const float* xr = H1 + (size_t)(row0 + rg * 32 + (lane & 31)) * DM + kq * 512 + (lane >> 5) * 8;
    const bf16_t* wh = WRH + (size_t)(lane & 31) * DM + kq * 512 + (lane >> 5) * 8; const bf16_t* wl = WRL + (size_t)(lane & 31) * DM + kq * 512 + (lane >> 5) * 8;
    f32x16 acc;
#pragma unroll
    for (int i = 0; i < 16; ++i) acc[i] = 0.f;
    float ss = 0.f;
#pragma unroll 4
    for (int ks = 0; ks < 32; ++ks) {
        const f32x4 x0 = ld4(xr + ks * 16), x1 = ld4(xr + ks * 16 + 4);
        ss += (x0[0] * x0[0] + x0[1] * x0[1]) + (x0[2] * x0[2] + x0[3] * x0[3]) + (x1[0] * x1[0] + x1[1] * x1[1]) + (x1[2] * x1[2] + x1[3] * x1[3]);
        union { u32x4 u; bf16x8 v; } ah, alo, bh, bl;
        ah.u = pack8(x0, x1);
        f32x4 h0, h1; unpack8(ah.u, h0, h1);
        alo.u = pack8(x0 - h0, x1 - h1);
        bh.u = ld16(wh + ks * 16); bl.u = ld16(wl + ks * 16);
        acc = __builtin_amdgcn_mfma_f32_32x32x16_bf16(ah.v, bh.v, acc, 0, 0, 0);
        acc = __builtin_amdgcn_mfma_f32_32x32x16_bf16(alo.v, bh.v, acc, 0, 0, 0);
        acc = __builtin_amdgcn_mfma_f32_32x32x16_bf16(ah.v, bl.v, acc, 0, 0, 0);
    }
    ss += __shfl_xor(ss, 32);
    if (lane < 32) ssp[wid * 32 + lane] = ss;
#pragma unroll
    for (int r = 0; r < 16; ++r) { const int row = (r & 3) + 8 * (r >> 2) + 4 * (lane >> 5); part[(wid * 32 + row) * 33 + (lane & 31)] = acc[r]; }
    __syncthreads();
    {
        const int r = tid >> 3, e0 = (tid & 7) * 4, g = r >> 5, rr = r & 31;
        const float sq = (ssp[(g * 4 + 0) * 32 + rr] + ssp[(g * 4 + 1) * 32 + rr]) + (ssp[(g * 4 + 2) * 32 + rr] + ssp[(g * 4 + 3) * 32 + rr]);
        const float rs = 1.0f / sqrtf(sq * (1.0f / DM) + RMS_EPS);
#pragma unroll
        for (int j = 0; j < 4; ++j) { const int e = e0 + j;
            const float d = (part[((g * 4 + 0) * 32 + rr) * 33 + e] + part[((g * 4 + 1) * 32 + rr) * 33 + e]) + (part[((g * 4 + 2) * 32 + rr) * 33 + e] + part[((g * 4 + 3) * 32 + rr) * 33 + e]);
            lg[r * 33 + e] = d * rs + b_r[e]; }
        if ((tid & 7) == 0) { rstd2[row0 + r] = rs; lrs[r] = rs; }
    }
    __syncthreads();
    int pe[4], pp[4]; float pv[4];
    if (tid < 64) {
        int used = 0;
#pragma unroll
        for (int k = 0; k < 4; ++k) { float best = -3.0e38f; int bi = 0;
            for (int e = 0; e < 32; ++e) { const float v = lg[tid * 33 + e]; const bool free_ = ((used >> e) & 1) == 0; if (free_ && v > best) { best = v; bi = e; } }
            used |= 1 << bi; pe[k] = bi; pv[k] = best; }
        const float m0 = pv[0]; float sum = 0.f;
#pragma unroll
        for (int k = 0; k < 4; ++k) { pv[k] = __expf(pv[k] - m0); sum += pv[k]; }
        const float inv = 1.0f / sum;
#pragma unroll
        for (int k = 0; k < 4; ++k) { pv[k] *= inv; pp[k] = atomicAdd((int*)&lcnt[pe[k]], 1); }
    }
    __syncthreads();
    if (tid < 32) gbase[tid] = (int)__hip_atomic_fetch_add(ecnt + 64 * tid, (unsigned)lcnt[tid], __ATOMIC_RELAXED, __HIP_MEMORY_SCOPE_AGENT);
    __syncthreads();
    if (tid < 64) {
        const int row = row0 + tid;
#pragma unroll
        for (int k = 0; k < 4; ++k) { const size_t ix = (size_t)pe[k] * NTOK + gbase[pe[k]] + pp[k]; elist[ix] = row * 4 + k; prs[ix] = lrs[tid]; pw[ix] = pv[k]; topw[row * 4 + k] = pv[k]; }
    }
    __syncthreads();
}

constexpr int NPH = 13;
#ifndef N_CONV_WG
#define N_CONV_WG 64
#endif
#define FRESH_TID() ({ int _t = threadIdx.x; asm volatile("" : "+v"(_t)); _t; })
#define WSP(T, off) ((T*)(ws + (off)))
__global__ void __launch_bounds__(NTHR, 2) mega(Args a) {
    extern __shared__ __attribute__((aligned(16))) unsigned char lds_raw[];
    LAS unsigned char* lds = (LAS unsigned char*)lds_raw;
    volatile LAS unsigned* MISC = (volatile LAS unsigned*)(lds + MISC_OFF);
    const int G = gridDim.x, bx = blockIdx.x, NGW = G * NWAVES;
    unsigned char* ws = a.ws; unsigned* ctl = (unsigned*)(ws + WS_CTL);
    const int lo = a.ph_lo, hi = a.ph_hi;
    if (threadIdx.x < 4) MISC[threadIdx.x] = 0u;
    __syncthreads();
    XcdBarrier bar; bar.bar = ctl + CW_BAR; bar.x = 0; bar.st = MISC;
    if (hi - lo > 1) bar = xcd_barrier_post(ctl + CW_BAR, MISC);
#ifndef PH_MASK
#define PH_MASK 0xFFFF
#endif
#ifndef REPEAT_MASK
#define REPEAT_MASK 0
#endif
#ifndef MOE2_REP_STUB
#define MOE2_REP_STUB 0
#endif
#define IN(k) (((PH_MASK >> (k)) & 1) && lo <= (k) && (k) < hi)
#define SEAM(k) do { if (IN(k) && IN((k) + 1)) xcd_barrier(bar); } while (0)
#define WAVE_IDS() const int tid = FRESH_TID(); const int lane = tid & 63, wave = __builtin_amdgcn_readfirstlane(tid >> 6), gw = bx * NWAVES + wave; (void)lane; (void)gw

    if (IN(0)) { WAVE_IDS(); p0_prologue(a, lds, gw, NGW, lane, wave); }
#if (REPEAT_MASK >> 0) & 1
    if (IN(0)) { WAVE_IDS(); p0_prologue(a, lds, gw, NGW, lane, wave); }
#endif
    SEAM(0);
    if (IN(1)) {
        WAVE_IDS(); volatile LAS int* mbox = (volatile LAS int*)(lds + MISC_OFF + 512);
        ProbInProj p; p.S.init(64, 42, G, bx); p.A = WSP(bf16_t, WS_XB); p.Bt = WSP(bf16_t, WS_WIN); p.rstd = WSP(float, WS_RSTD1); p.bias = a.in[4]; p.Z = WSP(bf16_t, WS_Z); p.GG = WSP(bf16_t, WS_GG);
        p.D.q = ctl + CW_QG1; p.D.slot = mbox; p.D.x0 = (int)(xb_xcc_id() & 7u); p.D.nper = 8 * PN_GA; p.D.pn0 = 0;
        ProbInProj8 p8; p8.XQ = WSP(unsigned char, WS_H1Q); p8.W8 = WSP(unsigned char, WS_WIN8); p8.rstd = WSP(float, WS_RSTD1); p8.bias = a.in[4]; p8.Z = WSP(bf16_t, WS_Z); p8.GG = WSP(bf16_t, WS_GG);
        p8.D.q = ctl + CW_QG1 + 32; p8.D.slot = mbox; p8.D.x0 = p.D.x0; p8.D.nper = 8 * (42 - PN_GA); p8.D.pn0 = PN_GA;
        const int per_wg = (NB_ALL + G - 1) / G;
#ifndef CONV_GROUPS
#define CONV_GROUPS 2
#endif
#define CONV_SLOT(sl) do { if ((bx % CONV_GROUPS) == (sl)) { \
            const int w0 = bx * per_wg; int n = per_wg; if (w0 + n > NB_ALL) n = NB_ALL - w0; \
            moe_convert_blocks(a.in[19], a.in[21], a.in[16], ws, w0, n, lds, wave, lane, a.in[25], a.in[23], a.in[3], a.in[2], a.in[13], a.in[14]); } } while (0)
#if PN8_FIRST > 0
        CONV_SLOT(0); p.D.quota = 4; gemm_phase(lds, p);
        CONV_SLOT(1); p.D.quota = 1 << 20; gemm_phase(lds, p);
        p8.D.quota = 1 << 20; gemm_phase(lds, p8);
#else
        (void)p;
        CONV_SLOT(0); p8.D.quota = P1_Q1; gemm_phase(lds, p8);
        CONV_SLOT(1); p8.D.quota = 1 << 20; gemm_phase(lds, p8);
#endif
#undef CONV_SLOT
    }
    SEAM(1);
    if (IN(2)) {
        WAVE_IDS();
#ifndef NO_ATTN
        for (int u = bx; u < 512; u += G) attn_unit(lds, WSP(bf16_t, WS_Z), a.in[12], WSP(bf16_t, WS_YA), u, tid);
#endif
#ifndef NO_CONV
        conv_items(WSP(bf16_t, WS_Z), a.in[5], a.in[6], WSP(bf16_t, WS_UC), gw, NGW, lane);
#endif
    }
#if (REPEAT_MASK >> 2) & 1
    if (IN(2)) {
        WAVE_IDS();
#ifndef REP_NO_ATTN
        for (int u = bx; u < 512; u += G) attn_unit(lds, WSP(bf16_t, WS_Z), a.in[12], WSP(bf16_t, WS_YA), u, tid);
#endif
#ifndef REP_NO_CONV
        conv_items(WSP(bf16_t, WS_Z), a.in[5], a.in[6], WSP(bf16_t, WS_UC), gw, NGW, lane);
#endif
    }
#endif
    SEAM(2);
    if (IN(3)) { ProbGates p; p.G = G; p.c = bx; p.UC = WSP(bf16_t, WS_UC); p.W = WSP(bf16_t, WS_WRG); p.b_a = a.in[8]; p.b_x = a.in[10]; p.lam = a.in[11]; p.LA2 = WSP(bf16_t, WS_LA2); p.XIN = WSP(bf16_t, WS_XIN); gemm_phase(lds, p); }
#if (REPEAT_MASK >> 3) & 1
    if (IN(3)) { ProbGates p; p.G = G; p.c = bx; p.UC = WSP(bf16_t, WS_UC); p.W = WSP(bf16_t, WS_WRG); p.b_a = a.in[8]; p.b_x = a.in[10]; p.lam = a.in[11]; p.LA2 = WSP(bf16_t, WS_LA2); p.XIN = WSP(bf16_t, WS_XIN); gemm_phase(lds, p); }
#endif
    SEAM(3);
    if (IN(4)) { WAVE_IDS(); for (int u = bx; u < 256; u += G) scan_unit(lds, WSP(bf16_t, WS_LA2), WSP(bf16_t, WS_XIN), WSP(bf16_t, WS_GG), WSP(bf16_t, WS_YL), u, tid); }
#if (REPEAT_MASK >> 4) & 1
    if (IN(4)) { WAVE_IDS(); for (int u = bx; u < 256; u += G) scan_unit(lds, WSP(bf16_t, WS_LA2), WSP(bf16_t, WS_XIN), WSP(bf16_t, WS_GG), WSP(bf16_t, WS_YL), u, tid); }
#endif
    SEAM(4);
    if (IN(5)) { ProbProj2 p; p.S.init(64, 8, G, bx); p.YA = WSP(bf16_t, WS_YA); p.YL = WSP(bf16_t, WS_YL); p.WA = WSP(bf16_t, WS_WAP); p.WL = WSP(bf16_t, WS_WLP); p.Z = WSP(bf16_t, WS_Z); p.MG = WSP(bf16_t, WS_MG); gemm_phase(lds, p); }
#if (REPEAT_MASK >> 5) & 1
    if (IN(5)) { ProbProj2 p; p.S.init(64, 8, G, bx); p.YA = WSP(bf16_t, WS_YA); p.YL = WSP(bf16_t, WS_YL); p.WA = WSP(bf16_t, WS_WAP); p.WL = WSP(bf16_t, WS_WLP); p.Z = WSP(bf16_t, WS_Z); p.MG = WSP(bf16_t, WS_MG); gemm_phase(lds, p); }
#endif
    SEAM(5);
    if (IN(6)) { ProbOut p; p.S.init(64, 8, G, bx); p.A = WSP(bf16_t, WS_MG); p.Bt = WSP(bf16_t, WS_WOUT); p.X = a.in[0]; p.H1 = WSP(float, WS_H1); p.H1Q = WSP(unsigned char, WS_H1Q); gemm_phase(lds, p); }
#if (REPEAT_MASK >> 6) & 1
    if (IN(6)) { ProbOut p; p.S.init(64, 8, G, bx); p.A = WSP(bf16_t, WS_MG); p.Bt = WSP(bf16_t, WS_WOUT); p.X = a.in[0]; p.H1 = WSP(float, WS_H1); p.H1Q = WSP(unsigned char, WS_H1Q); gemm_phase(lds, p); }
#endif
    SEAM(6);
    if (IN(7)) { WAVE_IDS(); for (int u = bx; u < 256; u += G) router_unit(lds, WSP(float, WS_H1), WSP(bf16_t, WS_WR), WSP(bf16_t, WS_WR) + NEXP * DM, a.in[18], WSP(float, WS_TOPW), WSP(float, WS_RSTD2), WSP(int, WS_ELIST), WSP(float, WS_PRS), WSP(float, WS_PW), ctl + CW_ECNT, u, tid); }
#if (REPEAT_MASK >> 7) & 1
    if (IN(7)) { WAVE_IDS(); for (int u = bx; u < 256; u += G) router_unit(lds, WSP(float, WS_H1), WSP(bf16_t, WS_WR), WSP(bf16_t, WS_WR) + NEXP * DM, a.in[18], WSP(float, WS_TOPW), WSP(float, WS_RSTD2), WSP(int, WS_ELIST), WSP(float, WS_PRS), WSP(float, WS_PW), ctl + CW_ECNT, u, tid); }
#endif
    SEAM(7);
    volatile LAS int* tab = (volatile LAS int*)(lds + MISC_OFF + 64);
    if (IN(8) || IN(9)) {
        if (threadIdx.x == 0) { int tp = 0, bp = 0;
            for (int e = 0; e < 32; ++e) { int cn = (int)__hip_atomic_load(ctl + CW_ECNT + 64 * e, __ATOMIC_RELAXED, __HIP_MEMORY_SCOPE_AGENT); cn = cn < 0 ? 0 : (cn > NTOK ? NTOK : cn); tab[e] = tp; tab[33 + e] = bp; tp += (cn + 255) >> 8; bp += cn; }
            tab[32] = tp; tab[65] = bp; }
        __syncthreads();
        if (threadIdx.x < 288) { const int g = threadIdx.x; int e = 0; for (int j = 0; j < 32; ++j) e += (g >= tab[j + 1]) ? 1 : 0; ((volatile LAS unsigned char*)(lds + MISC_OFF + 640))[g] = (unsigned char)(e > 31 ? 31 : e); }
        __syncthreads();
    }
    if (IN(8)) { ProbMoe1 p; p.G = G; p.c = bx; p.tab = tab; p.H1Q = WSP(unsigned char, WS_H1Q); p.W1 = WSP(unsigned char, WS_W1); p.elist = WSP(int, WS_ELIST); p.rstd2 = WSP(float, WS_RSTD2); p.prs = WSP(float, WS_PRS); p.b1 = a.in[20]; p.ACT = WSP(unsigned char, WS_ACT); gemm_phase(lds, p); }
#if (REPEAT_MASK >> 8) & 1
    if (IN(8)) { ProbMoe1 p; p.G = G; p.c = bx; p.tab = tab; p.H1Q = WSP(unsigned char, WS_H1Q); p.W1 = WSP(unsigned char, WS_W1); p.elist = WSP(int, WS_ELIST); p.rstd2 = WSP(float, WS_RSTD2); p.prs = WSP(float, WS_PRS); p.b1 = a.in[20]; p.ACT = WSP(unsigned char, WS_ACT); gemm_phase(lds, p); }
#endif
    SEAM(8);
    if (IN(9)) { ProbMoe2 p; p.G = G; p.c = bx; p.tab = tab; p.ACT = WSP(unsigned char, WS_ACT); p.W2 = WSP(unsigned char, WS_W2); p.elist = WSP(int, WS_ELIST); p.topw = WSP(float, WS_TOPW); p.pw = WSP(float, WS_PW); p.b2 = a.in[22]; p.YB = WSP(unsigned char, WS_YB); gemm_phase(lds, p); }
#if (REPEAT_MASK >> 9) & 1
    if (IN(9)) { ProbMoe2T<MOE2_REP_STUB> p; p.G = G; p.c = bx; p.tab = tab; p.ACT = WSP(unsigned char, WS_ACT); p.W2 = WSP(unsigned char, WS_W2); p.elist = WSP(int, WS_ELIST); p.topw = WSP(float, WS_TOPW); p.pw = WSP(float, WS_PW); p.b2 = a.in[22]; p.YB = WSP(unsigned char, WS_YB); gemm_phase(lds, p); }
#endif
    SEAM(9);
    if (IN(10)) {
        WAVE_IDS(); float* H1 = WSP(float, WS_H1); bf16_t* H1B = WSP(bf16_t, WS_H1B); const unsigned char* YB = WSP(unsigned char, WS_YB); float* RSTD3 = WSP(float, WS_RSTD3); unsigned char* H2Q = WSP(unsigned char, WS_H1Q);
        for (int m = gw; m < NTOK; m += NGW) {
            float ss = 0.f;
#pragma unroll
            for (int j = 0; j < 4; ++j) {
                const size_t o = (size_t)m * DM + j * 512 + lane * 8; f32x4 v0 = ld4(H1 + o), v1 = ld4(H1 + o + 4);
                f32x4 s0 = {0.f, 0.f, 0.f, 0.f}, s1 = s0;
#pragma unroll
                for (int k = 0; k < 4; ++k) { f32x4 y0, y1; unpack8_fp8(*(const GAS u32x2*)(YB + ((size_t)m * 4 + k) * DM + j * 512 + lane * 8), y0, y1); s0 += y0; s1 += y1; }
                v0 += s0 * (1.0f / YB8_SCALE); v1 += s1 * (1.0f / YB8_SCALE);
                ss += (v0[0] * v0[0] + v0[1] * v0[1]) + (v0[2] * v0[2] + v0[3] * v0[3]) + (v1[0] * v1[0] + v1[1] * v1[1]) + (v1[2] * v1[2] + v1[3] * v1[3]);
                st16(H1B + o, pack8(v0, v1));
                st8(H2Q + o, pack8_fp8(v0, v1));
            }
            ss = wave_sum(ss);
            if (lane == 0) RSTD3[m] = 1.0f / sqrtf(ss * (1.0f / DM) + RMS_EPS);
        }
    }
    SEAM(10);
    if (IN(11)) {
        { ProbPle p; p.S.init(64, 8, G, bx); p.A = WSP(bf16_t, WS_PB); p.Bt = WSP(bf16_t, WS_WPLE); p.PE = WSP(bf16_t, WS_PE); gemm_phase(lds, p); }
        { ProbGate8 p; p.S.init(64, 8, G, bx); p.H2Q = WSP(unsigned char, WS_H1Q); p.WPG8 = WSP(unsigned char, WS_WPG); p.H2B = WSP(bf16_t, WS_H1B); p.PE = WSP(bf16_t, WS_PE);
          p.rstd3 = WSP(float, WS_RSTD3); p.H3B = WSP(bf16_t, WS_M1); p.SS3 = WSP(float, WS_SS3); gemm_phase(lds, p); }
    }
    SEAM(11);
    if (IN(12)) {
        WAVE_IDS(); const float* gf = a.in[26]; const float* SS3 = WSP(float, WS_SS3); const bf16_t* H3B = WSP(bf16_t, WS_M1);
        for (int m = gw; m < NTOK; m += NGW) {
            float ss = (lane < 32) ? SS3[(size_t)m * 32 + lane] : 0.f; ss = wave_sum(ss);
            const float rs = 1.0f / sqrtf(ss * (1.0f / DM) + RMS_EPS);
#pragma unroll
            for (int j = 0; j < 4; ++j) { const size_t o = (size_t)m * DM + j * 512 + lane * 8; const int c = j * 512 + lane * 8;
                f32x4 h0, h1; unpack8(ld16(H3B + o), h0, h1);
                st4(a.out + o, h0 * rs * ld4(gf + c)); st4(a.out + o + 4, h1 * rs * ld4(gf + c + 4)); }
        }
    }
#ifdef DBG_STOP
    if (lo == 13) {
        WAVE_IDS(); const float* H1 = WSP(float, WS_H1); (void)H1;
#ifdef DBG_BUF
        const bf16_t* src = (const bf16_t*)(ws + DBG_BUF);
        for (int m = gw; m < NTOK; m += NGW) {
#pragma unroll
            for (int j = 0; j < 4; ++j) { const size_t o = (size_t)m * DM + j * 512 + lane * 8; f32x4 b0, b1; unpack8(ld16(src + (size_t)m * DBG_LD + DBG_COFF + j * 512 + lane * 8), b0, b1);
                for (int q = 0; q < 4; ++q) { if (!(fabsf(b0[q]) < 1e30f)) b0[q] = 1000.f; if (!(fabsf(b1[q]) < 1e30f)) b1[q] = 1000.f; }
                st4(a.out + o, ld4(a.in[0] + o) + b0); st4(a.out + o + 4, ld4(a.in[0] + o + 4) + b1); }
        }
#else
        const float* gf = a.in[26];
        for (int m = gw; m < NTOK; m += NGW) {
            float ss = 0.f; f32x4 v[8];
#pragma unroll
            for (int j = 0; j < 4; ++j) { const size_t o = (size_t)m * DM + j * 512 + lane * 8; v[2 * j] = ld4(H1 + o); v[2 * j + 1] = ld4(H1 + o + 4);
                for (int q = 0; q < 4; ++q) ss += v[2 * j][q] * v[2 * j][q] + v[2 * j + 1][q] * v[2 * j + 1][q]; }
            ss = wave_sum(ss);
            const float rs = 1.0f / sqrtf(ss * (1.0f / DM) + RMS_EPS);
#pragma unroll
            for (int j = 0; j < 4; ++j) { const size_t o = (size_t)m * DM + j * 512 + lane * 8; const int c = j * 512 + lane * 8;
                st4(a.out + o, v[2 * j] * rs * ld4(gf + c)); st4(a.out + o + 4, v[2 * j + 1] * rs * ld4(gf + c + 4)); }
        }
#endif
    }
#endif
#undef IN
#undef SEAM
}

extern "C" void kernel_launch(void* const* d_in, const int* in_sizes, int n_in, void* d_out, int out_size, void* d_ws, size_t ws_size, hipStream_t stream) {
    static int grid = 0;
    if (grid == 0) {
        if (n_in != 27 || out_size != NTOK * DM || ws_size < WS_END) { fprintf(stderr, "kernel_launch: unexpected shapes (n_in %d out %d ws %zu need %zu)\n", n_in, out_size, ws_size, (size_t)WS_END); grid = -1; return; }
        int dev = 0, cus = 0, per_cu = 0;
        if (hipGetDevice(&dev) != hipSuccess || hipDeviceGetAttribute(&cus, hipDeviceAttributeMultiprocessorCount, dev) != hipSuccess) { grid = -1; return; }
        if (hipFuncSetAttribute((const void*)mega, hipFuncAttributeMaxDynamicSharedMemorySize, LDS_BYTES) != hipSuccess) { fprintf(stderr, "kernel_launch: hipFuncSetAttribute failed\n"); grid = -1; return; }
        if (hipOccupancyMaxActiveBlocksPerMultiprocessor(&per_cu, (const void*)mega, NTHR, LDS_BYTES) != hipSuccess || per_cu < 1) fprintf(stderr, "kernel_launch: occupancy query says %d\n", per_cu);
        (void)hipGetLastError();
        grid = cus;
    }
    if (grid < 0) return;
    (void)hipMemsetAsync((char*)d_ws + WS_CTL, 0, CTL_BYTES, stream);
    Args a{};
    for (int i = 0; i < 27; ++i) a.in[i] = (const float*)d_in[i];
    a.out = (float*)d_out; a.ws = (unsigned char*)d_ws;
#if MK_SINGLE
    a.ph_lo = 0; a.ph_hi = NPH;
    hipLaunchKernelGGL(mega, dim3(grid), dim3(NTHR), LDS_BYTES, stream, a);
#else
#ifdef DBG_STOP
    for (int ph = 0; ph <= DBG_STOP; ++ph) { a.ph_lo = ph; a.ph_hi = ph + 1; hipLaunchKernelGGL(mega, dim3(grid), dim3(NTHR), LDS_BYTES, stream, a); }
    a.ph_lo = 13; a.ph_hi = 14; hipLaunchKernelGGL(mega, dim3(grid), dim3(NTHR), LDS_BYTES, stream, a);
#else
    for (int ph = 0; ph < NPH; ++ph) { a.ph_lo = ph; a.ph_hi = ph + 1; hipLaunchKernelGGL(mega, dim3(grid), dim3(NTHR), LDS_BYTES, stream, a); }
#endif
#endif
}
```

```cpp
#include <hip/hip_runtime.h>
#include <stdint.h>
#include <stdio.h>

#ifndef PN8_FIRST
#define PN8_FIRST 0
#endif
#ifndef P1_Q1
#define P1_Q1 7
#endif
#ifndef MK_SINGLE
#define MK_SINGLE 1
#endif

#ifndef ATT_DBG
#define ATT_DBG 0
#endif
#define LAS __attribute__((address_space(3)))
#define GAS __attribute__((address_space(1)))
typedef unsigned short bf16_t;
typedef short bf16x8 __attribute__((ext_vector_type(8)));
typedef float f32x4 __attribute__((ext_vector_type(4)));
typedef float f32x16 __attribute__((ext_vector_type(16)));
typedef unsigned u32x4 __attribute__((ext_vector_type(4)));
typedef unsigned u32x2 __attribute__((ext_vector_type(2)));
typedef int i32x8 __attribute__((ext_vector_type(8)));
typedef int i32x4 __attribute__((ext_vector_type(4)));

constexpr int NTOK = 16384, SEQ = 4096, DM = 2048, INW = 10752;
constexpr int COL_Q = 0, COL_K = 2048, COL_V = 2304, COL_U = 2560, COL_GATE = 4608, COL_GA = 6656, COL_GL = 8704;
constexpr int NEXP = 32, TOPK = 4, DFF = 2048, PLE = 256;
constexpr float RMS_EPS = 1e-6f;
constexpr float QK_SCALE = 0.125f * 1.4426950409f;

constexpr size_t MiB = 1u << 20;
constexpr size_t al(size_t x) { return (x + 4095) & ~(size_t)4095; }
constexpr size_t WS_CTL = 0, CTL_BYTES = 1 * MiB;
constexpr size_t WS_WIN = CTL_BYTES;
constexpr size_t WS_WIN8 = WS_WIN + (size_t)(PN8_FIRST * 256) * DM * 2;
constexpr size_t WS_WAP = WS_WIN + al((size_t)INW * DM * 2);
constexpr size_t WS_WLP = WS_WAP + al((size_t)DM * DM * 2);
constexpr size_t WS_WOUT = WS_WLP + al((size_t)DM * DM * 2);
constexpr size_t WS_WPG = WS_WOUT + al((size_t)DM * DM * 2);
constexpr size_t WS_WPLE = WS_WPG + al((size_t)DM * DM * 2);
constexpr size_t WS_WRG = WS_WPLE + al((size_t)DM * PLE * 2);
constexpr size_t WS_WR = WS_WRG + al((size_t)2 * 8 * 256 * 256 * 2);
constexpr size_t WS_W1 = WS_WR + al((size_t)2 * NEXP * DM * 2);
constexpr size_t WS_W2 = WS_W1 + al((size_t)NEXP * 2 * DFF * DM * 2);
constexpr size_t WS_XB = WS_W2 + al((size_t)NEXP * DM * DFF * 2);
constexpr size_t WS_RSTD1 = WS_XB + al((size_t)NTOK * DM * 2);
constexpr size_t WS_Z = WS_RSTD1 + al((size_t)NTOK * 4);
constexpr size_t WS_YA = WS_Z + al((size_t)NTOK * INW * 2);
constexpr size_t WS_UC = WS_YA + al((size_t)NTOK * DM * 2);
constexpr size_t WS_LA2 = WS_UC + al((size_t)NTOK * DM * 2);
constexpr size_t WS_GG = WS_LA2 + al((size_t)NTOK * DM * 2);
constexpr size_t WS_XIN = WS_GG + al((size_t)NTOK * DM * 2);
constexpr size_t WS_YL = WS_XIN + al((size_t)NTOK * DM * 2);
constexpr size_t WS_M1 = WS_YL + al((size_t)NTOK * DM * 2);
constexpr size_t WS_MG = WS_M1 + al((size_t)NTOK * DM * 4);
constexpr size_t WS_H1 = WS_MG + al((size_t)NTOK * DM * 2);
constexpr size_t WS_H1B = WS_H1 + al((size_t)NTOK * DM * 4);
constexpr size_t WS_TOPW = WS_H1B + al((size_t)NTOK * DM * 2);
constexpr size_t WS_RSTD2 = WS_TOPW + al((size_t)NTOK * 4 * 4);
constexpr size_t WS_RSTD3 = WS_RSTD2 + al((size_t)NTOK * 4);
constexpr size_t WS_ELIST = WS_RSTD3 + al((size_t)NTOK * 4);
constexpr size_t WS_ACT = WS_ELIST + al((size_t)NEXP * NTOK * 4);
constexpr size_t WS_YB = WS_ACT + al((size_t)(NTOK * 4 + 512) * DFF * 2);
constexpr size_t WS_PB = WS_YB + al((size_t)NTOK * 4 * DM * 2);
constexpr size_t WS_PE = WS_PB + al((size_t)NTOK * PLE * 2);
constexpr size_t WS_SS3 = WS_PE + al((size_t)NTOK * DM * 4);
constexpr size_t WS_H1Q = WS_SS3 + al((size_t)NTOK * 32 * 4);
constexpr size_t WS_PRS = WS_H1Q + al((size_t)NTOK * DM);
constexpr size_t WS_PW = WS_PRS + al((size_t)NEXP * NTOK * 4);
constexpr size_t WS_END = WS_PW + al((size_t)NEXP * NTOK * 4);
constexpr int CW_BAR = 1024;
constexpr int CW_ECNT = 8192;
constexpr int CW_QCONV = 12288;
constexpr int CW_QG1 = 12352;

constexpr int NWAVES = 8, NTHR = 512;
constexpr int LDS_BYTES = 147456, MISC_OFF = 146432;

typedef float f32x2 __attribute__((ext_vector_type(2)));
typedef __bf16 bf16v2 __attribute__((ext_vector_type(2)));
__device__ __forceinline__ unsigned pk2(float lo, float hi) { f32x2 f = {lo, hi}; bf16v2 b = __builtin_convertvector(f, bf16v2); return __builtin_bit_cast(unsigned, b); }
__device__ __forceinline__ float bflo(unsigned u) { return __uint_as_float(u << 16); }
__device__ __forceinline__ float bfhi(unsigned u) { return __uint_as_float(u & 0xffff0000u); }
__device__ __forceinline__ float fsigmoid(float x) { return __builtin_amdgcn_rcpf(1.0f + __builtin_amdgcn_exp2f(-1.4426950409f * x)); }
__device__ __forceinline__ float gelu_tanh(float x) { const float t = 0.7978845608f * (x + 0.044715f * x * x * x); return x * fsigmoid(2.0f * t); }
__device__ __forceinline__ float wave_sum(float v) {
#pragma unroll
    for (int o = 1; o < 64; o <<= 1) v += __shfl_xor(v, o);
    return v;
}
#define LDS_WAIT() asm volatile("s_waitcnt lgkmcnt(0)" ::: "memory")
#define VM_WAIT() asm volatile("s_waitcnt vmcnt(0)" ::: "memory")

#define XB_TMO      128
#define XB_XCNT(j)  (256  + 64 * (j))
#define XB_XSUB(j)  (1280 + 64 * (j))
#define XB_XGEN(j)  (2304 + 64 * (j))
#define XB_TOP      3328
#define XB_TOPGEN   3392
#define XCD_BAR_WORDS 3456
#define XB_SPIN_CAP (1u << 18)
__device__ __forceinline__ unsigned xb_ld(unsigned* p)              { return __hip_atomic_load(p, __ATOMIC_RELAXED, __HIP_MEMORY_SCOPE_AGENT); }
__device__ __forceinline__ unsigned xb_add(unsigned* p, unsigned v) { return __hip_atomic_fetch_add(p, v, __ATOMIC_RELAXED, __HIP_MEMORY_SCOPE_AGENT); }
__device__ __forceinline__ unsigned xb_xcc_id() { return (unsigned)__builtin_amdgcn_s_getreg((3 << 11) | 20) & 0xFu; }
#define XB_SPIN(cond, bar) do { unsigned _sp = 0; while (cond) { __builtin_amdgcn_s_sleep(1); \
    if ((++_sp & 255u) == 0u) { if (xb_ld(&(bar)[XB_TMO])) break; if (_sp > XB_SPIN_CAP) { atomicAdd(&(bar)[XB_TMO], 1u); break; } } } } while (0)
struct XcdBarrier { unsigned* bar; unsigned x; volatile LAS unsigned* st; };
__device__ __forceinline__ XcdBarrier xcd_barrier_post(unsigned* bar, volatile LAS unsigned* st) {
    XcdBarrier b; b.bar = bar; b.x = xb_xcc_id(); b.st = st;
    if (threadIdx.x == 0) (void)xb_add(&bar[XB_XCNT(b.x)], 1u);
    return b;
}
__device__ __forceinline__ void xcd_barrier_complete(unsigned* bar, unsigned x, unsigned& nloc, unsigned& nx) {
    const unsigned G = gridDim.x * gridDim.y * gridDim.z;
    unsigned sum, cnt, mine, sp = 0u;
    for (;;) {
        sum = 0u; cnt = 0u; mine = 0u;
#pragma unroll
        for (unsigned j = 0; j < 16; ++j) { const unsigned c = xb_ld(&bar[XB_XCNT(j)]); sum += c; cnt += (c > 0u) ? 1u : 0u; mine = (j == x) ? c : mine; }
        if (sum == G) break;
        __builtin_amdgcn_s_sleep(1);
        if ((++sp & 255u) == 0u) { if (xb_ld(&bar[XB_TMO])) break; if (sp > XB_SPIN_CAP) { atomicAdd(&bar[XB_TMO], 1u); break; } }
    }
    nloc = mine > 0u ? mine : 1u; nx = cnt > 0u ? cnt : 1u;
}
__device__ __forceinline__ void xcd_barrier(const XcdBarrier& b) {
    asm volatile("s_waitcnt vmcnt(0)" ::: "memory");
    __syncthreads();
    if (threadIdx.x == 0) {
        unsigned* bar = b.bar;
        __builtin_amdgcn_s_waitcnt(0);
        unsigned nloc = b.st[0], nx = b.st[1];
        if (nloc == 0u) { xcd_barrier_complete(bar, b.x, nloc, nx); b.st[0] = nloc; b.st[1] = nx; }
        const unsigned old = xb_add(&bar[XB_XSUB(b.x)], 1u);
        const unsigned gen = old / nloc;
        if (old + 1u == (gen + 1u) * nloc) {
            __builtin_amdgcn_fence(__ATOMIC_RELEASE, "agent");
            asm volatile("s_waitcnt vmcnt(0)" ::: "memory");
            const unsigned og = xb_add(&bar[XB_TOP], 1u);
            const unsigned tg = og / nx;
            if (og + 1u == (tg + 1u) * nx) xb_add(&bar[XB_TOPGEN], 1u);
            else XB_SPIN(xb_ld(&bar[XB_TOPGEN]) == tg, bar);
            __builtin_amdgcn_fence(__ATOMIC_ACQUIRE, "agent");
            xb_add(&bar[XB_XGEN(b.x)], 1u);
            asm volatile("s_waitcnt vmcnt(0)" ::: "memory");
        } else {
            XB_SPIN(xb_ld(&bar[XB_XGEN(b.x)]) == gen, bar);
            __builtin_amdgcn_fence(__ATOMIC_ACQUIRE, "agent");
            asm volatile("s_waitcnt vmcnt(0)" ::: "memory");
        }
    }
    __syncthreads();
}

namespace g8 {
constexpr int BM = 256, BK = 64, HALF = 128, HTB = HALF * BK * 2, STAGE_BYTES = 8 * HTB, NXCD = 8, WGM = 8;
__device__ __forceinline__ int lds_byte(int r, int c) { const int st = (r >> 4) * 2 + (c >> 5), rr = r & 15, cc = c & 31, ob = rr * 64 + cc * 2; return st * 1024 + (ob ^ (((ob >> 9) & 1) << 5)); }
__device__ __forceinline__ void stage_rc(int b, int& R, int& C) { const int st = b / 1024, sb = b % 1024, swz = sb ^ (((sb >> 9) & 1) << 5); R = (st >> 1) * 16 + swz / 64; C = (st & 1) * 32 + (swz % 64) / 2; }
__device__ __forceinline__ int perm32(int rho) { const int n = rho >> 4, i = rho & 15; return 8 * (i >> 2) + 4 * n + (i & 3); }

typedef __amdgpu_buffer_rsrc_t Rsrc;
__device__ __forceinline__ Rsrc mk_rsrc(const void* p) {
    const unsigned long long a = (unsigned long long)p; const unsigned lo = __builtin_amdgcn_readfirstlane((unsigned)a), hi = __builtin_amdgcn_readfirstlane((unsigned)(a >> 32));
    return __builtin_amdgcn_make_buffer_rsrc((void*)(((unsigned long long)hi << 32) | lo), 0, 0x7fffffff, 0x00020000); }
__device__ __forceinline__ unsigned voff_b(int tid, int ldbb) { int tz = tid; asm volatile("" : "+v"(tz)); int R, C; stage_rc(tz * 16, R, C); const int Rb = (R & ~31) + perm32(R & 31); return (unsigned)(Rb * ldbb + C * 2); }
struct Unit2 { int pm, pn; };
struct StaticOrder {
    int nM, nN, nwg, G, c;
    __device__ void init(int nM_, int nN_, int G_, int c_) { nM = nM_; nN = nN_; nwg = nM * nN; G = G_; c = c_; }
    __device__ bool next(int i, Unit2& u) const {
        const long L = (long)i * G + c; if (L >= nwg) return false;
        int wgid = (int)L; { const int q = nwg / NXCD, r = nwg % NXCD, xcd = wgid % NXCD, off = wgid / NXCD; wgid = (xcd < r ? xcd * (q + 1) : r * (q + 1) + (xcd - r) * q) + off; }
        const int nig = WGM * nN, gid = wgid / nig, fm = gid * WGM, gsz = (nM - fm) < WGM ? (nM - fm) : WGM;
        u.pm = fm + ((wgid % nig) % gsz); u.pn = (wgid % nig) / gsz; return true;
    }
};

template <class P>
__device__ __forceinline__ void gemm_phase(LAS unsigned char* lds, const P& p) {
    int tid = threadIdx.x; asm volatile("" : "+v"(tid));
    const int wid = __builtin_amdgcn_readfirstlane(tid >> 6), lane = tid & 63, wr = wid >> 2, wc = wid & 3, fr = lane & 15, fq = lane >> 4;
    const unsigned ldsw = (unsigned)wid * 1024u;
    int aoff = lds_byte(wr * 64 + fr, fq * 8), boff = lds_byte(wc * 32 + fr, fq * 8) + 4 * HTB;
    asm volatile("" : "+v"(aoff), "+v"(boff));
    const LAS unsigned char* ldsA = lds + aoff; const LAS unsigned char* ldsB = lds + boff;
#define G8_SA(b, h) (((b) * 2 + (h)) * HTB)
#define G8_SB(b, h) ((4 + (b) * 2 + (h)) * HTB)
#define G8_STAGE1(bufoff, rs, vo, so) __builtin_amdgcn_raw_ptr_buffer_load_lds(rs, (LAS void*)(lds + (bufoff) + ldsw), 16, (int)(vo), (int)(so), 0, 0)
#define G8_STAGE_B(bufoff, so) do { G8_STAGE1(bufoff, rB, voffB, so); G8_STAGE1((bufoff) + 8192, rB, voffB, (so) + b64); } while (0)
#define G8_STAGE_A(bufoff, rs, o, h, so) do { if constexpr (P::GATHER) { G8_STAGE1(bufoff, rs, o[2 * (h)], so); G8_STAGE1((bufoff) + 8192, rs, o[2 * (h) + 1], so); } \
        else { G8_STAGE1(bufoff, rs, o[0], (so) + (h) * 2 * a64); G8_STAGE1((bufoff) + 8192, rs, o[0], (so) + ((h) * 2 + 1) * a64); } } while (0)
#define G8_LD8(dst, base, off) do { const i32x4 _lo = *(const LAS i32x4*)((base) + (off)), _hi = *(const LAS i32x4*)((base) + (off) + 1024); dst = __builtin_shufflevector(_lo, _hi, 0, 1, 2, 3, 4, 5, 6, 7); } while (0)
#define G8_LDA(dst, b, h) do { _Pragma("unroll") for (int m = 0; m < 4; ++m) G8_LD8(dst[m], ldsA, G8_SA(b, h) + m * 2048); } while (0)
#define G8_LDB(dst, b, h) do { _Pragma("unroll") for (int n = 0; n < 2; ++n) G8_LD8(dst[n], ldsB, G8_SB(b, h) - 4 * HTB + n * 2048); } while (0)
#define G8_H(v, k) __builtin_bit_cast(bf16x8, __builtin_shufflevector(v, v, 4 * (k), 4 * (k) + 1, 4 * (k) + 2, 4 * (k) + 3))
#define G8_MMA(ai, bj, At, Bt) do { __builtin_amdgcn_s_setprio(1); \
        if constexpr (P::FP8) { _Pragma("unroll") for (int m = 0; m < 4; ++m) _Pragma("unroll") for (int n = 0; n < 2; ++n) \
            acc[ai][bj][m][n] = __builtin_amdgcn_mfma_scale_f32_16x16x128_f8f6f4(Bt[n], At[m], acc[ai][bj][m][n], 0, 0, 0, 0, 0, 0); } \
        else { _Pragma("unroll") for (int m = 0; m < 4; ++m) _Pragma("unroll") for (int n = 0; n < 2; ++n) { \
            acc[ai][bj][m][n] = __builtin_amdgcn_mfma_f32_16x16x32_bf16(G8_H(Bt[n], 0), G8_H(At[m], 0), acc[ai][bj][m][n], 0, 0, 0); \
            acc[ai][bj][m][n] = __builtin_amdgcn_mfma_f32_16x16x32_bf16(G8_H(Bt[n], 1), G8_H(At[m], 1), acc[ai][bj][m][n], 0, 0, 0); } } \
        __builtin_amdgcn_s_setprio(0); } while (0)
#define G8_WAIT_V(n) asm volatile("s_waitcnt vmcnt(" #n ")" ::: "memory")
#define G8_WAIT_L(n) asm volatile("s_waitcnt lgkmcnt(" #n ")" ::: "memory")
#define G8_BAR __builtin_amdgcn_s_barrier()
#define G8_SCHED __builtin_amdgcn_sched_barrier(0)
    typename P::Unit cur, nxt; int ui = 0;
    if (!p.next(0, cur)) return;
    i32x8 At[4], B0[2], B1[2];
    Rsrc rA, rB; int dB, a64, b64, nt; unsigned voffB; unsigned oA[P::GATHER ? 4 : 1];
    p.setup(cur, tid, rA, rB, dB, oA, voffB, a64, b64); nt = p.ntiles(cur);
    G8_STAGE_B(G8_SB(0, 0), 0); G8_STAGE_B(G8_SB(0, 1), dB); G8_STAGE_A(G8_SA(0, 0), rA, oA, 0, 0); G8_STAGE_A(G8_SA(0, 1), rA, oA, 1, 0);
    if (wr == 1) G8_BAR;
    G8_WAIT_V(2); G8_BAR;
    G8_STAGE_B(G8_SB(1, 0), 128); G8_STAGE_A(G8_SA(1, 0), rA, oA, 0, 128); G8_STAGE_B(G8_SB(1, 1), dB + 128);
    G8_WAIT_V(6); G8_BAR;
    f32x4 acc[2][2][4][2];
#pragma unroll
    for (int a = 0; a < 2; ++a)
#pragma unroll
        for (int b = 0; b < 2; ++b)
#pragma unroll
            for (int m = 0; m < 4; ++m)
#pragma unroll
                for (int n = 0; n < 2; ++n) acc[a][b][m][n] = (f32x4){0.f, 0.f, 0.f, 0.f};
    for (;;) {
        const bool has_next = p.next(ui + 1, nxt);
#pragma unroll 1
        for (int t = 0; t < nt; t += 2) {
            const bool last = (t == nt - 2);
            G8_STAGE_A(G8_SA(1, 1), rA, oA, 1, (t + 1) * 128);
            int k2 = (t + 2) * 128;
            if (last) { k2 = 0; if (has_next) p.setup(nxt, tid, rA, rB, dB, oA, voffB, a64, b64); }
            G8_LDB(B0, 0, 0); G8_LDB(B1, 0, 1); G8_SCHED; G8_LDA(At, 0, 0);
            G8_WAIT_V(8); G8_WAIT_L(0); G8_BAR; G8_MMA(0, 0, At, B0); G8_MMA(0, 1, At, B1); G8_BAR; G8_SCHED;
            G8_LDA(At, 0, 1); G8_STAGE_B(G8_SB(0, 0), k2); G8_STAGE_B(G8_SB(0, 1), dB + k2); G8_STAGE_A(G8_SA(0, 0), rA, oA, 0, k2);
            G8_WAIT_V(8); G8_WAIT_L(0); G8_BAR; G8_MMA(1, 0, At, B0); G8_MMA(1, 1, At, B1); G8_BAR; G8_SCHED;
            G8_LDB(B0, 1, 0); G8_LDB(B1, 1, 1); G8_SCHED; G8_LDA(At, 1, 0); G8_STAGE_A(G8_SA(0, 1), rA, oA, 1, k2);
            G8_WAIT_V(8); G8_WAIT_L(0); G8_BAR; G8_MMA(0, 0, At, B0); G8_MMA(0, 1, At, B1); G8_BAR; G8_SCHED;
            G8_LDA(At, 1, 1); G8_STAGE_B(G8_SB(1, 0), k2 + 128); G8_STAGE_B(G8_SB(1, 1), dB + k2 + 128); G8_STAGE_A(G8_SA(1, 0), rA, oA, 0, k2 + 128);
            G8_WAIT_V(8); G8_WAIT_L(0); G8_BAR; G8_MMA(1, 0, At, B0); G8_MMA(1, 1, At, B1); G8_BAR; G8_SCHED;
        }
        if (wr == 0) G8_BAR;
        {
            int tz = threadIdx.x; asm volatile("" : "+v"(tz));
            const int lz = tz & 63, wz = __builtin_amdgcn_readfirstlane(tz >> 6);
            p.epi(acc, cur, wz >> 2, wz & 3, lz & 15, lz >> 4);
        }
        if (!has_next) break;
        if (!p.keep_acc(cur)) {
#pragma unroll
        for (int a = 0; a < 2; ++a)
#pragma unroll
            for (int b = 0; b < 2; ++b)
#pragma unroll
                for (int m = 0; m < 4; ++m)
#pragma unroll
                    for (int n = 0; n < 2; ++n) acc[a][b][m][n] = (f32x4){0.f, 0.f, 0.f, 0.f};
        }
        cur = nxt; ++ui; nt = p.ntiles(cur);
        if (wr == 1) G8_BAR;
    }
    G8_WAIT_V(0);
    G8_BAR;
#undef G8_SA
#undef G8_SB
#undef G8_STAGE1
#undef G8_STAGE_A
#undef G8_STAGE_B
#undef G8_LDA
#undef G8_LD8
#undef G8_H
#undef G8_LDB
#undef G8_MMA
#undef G8_WAIT_V
#undef G8_WAIT_L
#undef G8_BAR
#undef G8_SCHED
}

template <int LDA_, int LDB_, int K_>
struct DenseBase {
    static constexpr int K = K_, LDA = LDA_, LDB = LDB_, LDBB = LDB_ * 2, LDAB = LDA_ * 2;
    static constexpr bool FP8 = false, GATHER = false;
    typedef Unit2 Unit;
    StaticOrder S; const bf16_t* A; const bf16_t* Bt;
    __device__ __forceinline__ bool next(int i, Unit& u) const { return S.next(i, u); }
    __device__ __forceinline__ bool keep_acc(const Unit&) const { return false; }
    __device__ __forceinline__ int ntiles(const Unit&) const { return K * 2 / 128; }
    __device__ __forceinline__ void setup(const Unit& u, int tid, Rsrc& ra, Rsrc& rb, int& db, unsigned (&o)[1], unsigned& vb, int& a64, int& b64) const {
        vb = voff_b(tid, LDBB); a64 = 64 * LDAB; b64 = 64 * LDBB;
        ra = mk_rsrc((const char*)A + (size_t)u.pm * 256 * LDA * 2);
        { int tz = tid; asm volatile("" : "+v"(tz)); int R, C; stage_rc(tz * 16, R, C); o[0] = (unsigned)(R * LDA + C) * 2u; }
        rb = mk_rsrc((const char*)Bt + (size_t)u.pn * 256 * LDB * 2); db = 128 * LDB * 2;
    }
};
}
using g8::gemm_phase;
typedef f32x4 Acc[2][2][4][2];

__device__ __forceinline__ f32x4 ld4(const float* p) { return *(const GAS f32x4*)p; }
__device__ __forceinline__ void st4(float* p, f32x4 v) { *(GAS f32x4*)p = v; }
__device__ __forceinline__ u32x4 ld16(const bf16_t* p) { return *(const GAS u32x4*)p; }
__device__ __forceinline__ void st16(bf16_t* p, u32x4 v) { *(GAS u32x4*)p = v; }
__device__ __forceinline__ u32x4 pack8(f32x4 a, f32x4 b) { u32x4 w; w.x = pk2(a[0], a[1]); w.y = pk2(a[2], a[3]); w.z = pk2(b[0], b[1]); w.w = pk2(b[2], b[3]); return w; }
__device__ __forceinline__ void unpack8(u32x4 w, f32x4& a, f32x4& b) { a = (f32x4){bflo(w.x), bfhi(w.x), bflo(w.y), bfhi(w.y)}; b = (f32x4){bflo(w.z), bfhi(w.z), bflo(w.w), bfhi(w.w)}; }

__device__ __forceinline__ u32x2 pack8_fp8(f32x4 a, f32x4 b) { int w0 = 0, w1 = 0;
#pragma unroll
    for (int j = 0; j < 4; ++j) { a[j] = __builtin_amdgcn_fmed3f(a[j], -448.0f, 448.0f); b[j] = __builtin_amdgcn_fmed3f(b[j], -448.0f, 448.0f); }
    w0 = __builtin_amdgcn_cvt_pk_fp8_f32(a[0], a[1], w0, false); w0 = __builtin_amdgcn_cvt_pk_fp8_f32(a[2], a[3], w0, true);
    w1 = __builtin_amdgcn_cvt_pk_fp8_f32(b[0], b[1], w1, false); w1 = __builtin_amdgcn_cvt_pk_fp8_f32(b[2], b[3], w1, true);
    u32x2 r; r.x = (unsigned)w0; r.y = (unsigned)w1; return r; }
__device__ __forceinline__ void st8(unsigned char* p, u32x2 v) { *(GAS u32x2*)p = v; }
__device__ __forceinline__ void unpack8_fp8(u32x2 w, f32x4& a, f32x4& b) { const f32x2 a0 = __builtin_amdgcn_cvt_pk_f32_fp8((int)w.x, false), a1 = __builtin_amdgcn_cvt_pk_f32_fp8((int)w.x, true), b0 = __builtin_amdgcn_cvt_pk_f32_fp8((int)w.y, false), b1 = __builtin_amdgcn_cvt_pk_f32_fp8((int)w.y, true);
    a = (f32x4){a0[0], a0[1], a1[0], a1[1]}; b = (f32x4){b0[0], b0[1], b1[0], b1[1]}; }
constexpr float W8_SCALE = 64.0f, ACT8_SCALE = 4.0f, YB8_SCALE = 32.0f, Y8_SCALE = 16.0f, MG8_SCALE = 64.0f;

struct DynOrder8 {
    unsigned* q; volatile LAS int* slot; int x0; mutable int quota; int nper, pn0;
    __device__ __forceinline__ bool next(int, g8::Unit2& u) const {
        if (quota <= 0) return false;
        --quota;
        if (threadIdx.x == 0) { int L = -1;
            for (int k = 0; k < 8; ++k) { const int x = (x0 + k) & 7; const unsigned v = __hip_atomic_fetch_add(q + 64 * x, 1u, __ATOMIC_RELAXED, __HIP_MEMORY_SCOPE_AGENT); if (v < (unsigned)nper) { L = (x << 16) | (int)v; break; } }
            *slot = L; }
        asm volatile("s_waitcnt lgkmcnt(0)" ::: "memory"); __builtin_amdgcn_s_barrier(); asm volatile("" ::: "memory");
        const int L = __builtin_amdgcn_readfirstlane(*slot);
        if (L < 0) return false;
        const int x = L >> 16, i = L & 0xffff; u.pm = 8 * x + (i & 7); u.pn = pn0 + (i >> 3); return true;
    }
};

__device__ __forceinline__ size_t cg_index(int row, int c) { return ((size_t)((row >> 12) * 64 + (c >> 5)) * SEQ + (row & (SEQ - 1))) * 32 + (c & 31); }

template <int MODE> struct ProbInProjT : g8::DenseBase<DM, DM, DM> {
    const float* rstd; const float* bias; bf16_t* Z; bf16_t* GG; DynOrder8 D;
    __device__ __forceinline__ bool next(int i, Unit& u) const { return D.next(i, u); }
    __device__ __forceinline__ void epi(Acc& acc, const Unit& u, int wr, int wc, int fr, int fq) const {
        if (MODE == 2) { f32x4 t = {0.f, 0.f, 0.f, 0.f};
#pragma unroll
            for (int a_ = 0; a_ < 2; ++a_)
#pragma unroll
                for (int b_ = 0; b_ < 2; ++b_)
#pragma unroll
                    for (int m_ = 0; m_ < 4; ++m_)
#pragma unroll
                        for (int n_ = 0; n_ < 2; ++n_) t += acc[a_][b_][m_][n_];
            if (t[0] + t[1] + t[2] + t[3] == 1.2345e30f) Z[0] = 1; return; }
        const int colt = u.pn * 256; const int kind = (MODE == 1) ? 0 : (colt < COL_GATE ? 0 : (colt < COL_GA ? 1 : 2));
        const int row0 = u.pm * 256 + wr * 64 + fr, col0 = colt + wc * 32 + 8 * fq;
        f32x4 bv[2][2];
#pragma unroll
        for (int bj = 0; bj < 2; ++bj) { bv[bj][0] = ld4(bias + col0 + bj * 128); bv[bj][1] = ld4(bias + col0 + bj * 128 + 4); }
        float rsv[8];
#pragma unroll
        for (int q = 0; q < 8; ++q) rsv[q] = rstd[row0 + (q >> 2) * 128 + (q & 3) * 16];
#pragma unroll
        for (int ai = 0; ai < 2; ++ai)
#pragma unroll
            for (int m = 0; m < 4; ++m) {
                const int row = row0 + ai * 128 + m * 16; const float rs = rsv[ai * 4 + m];
#pragma unroll
                for (int bj = 0; bj < 2; ++bj) {
                    f32x4 v0 = acc[ai][bj][m][0] * rs + bv[bj][0], v1 = acc[ai][bj][m][1] * rs + bv[bj][1];
                    if (colt < COL_K) { v0 *= QK_SCALE; v1 *= QK_SCALE; }
                    if (kind == 1) {
#pragma unroll
                        for (int j = 0; j < 4; ++j) { v0[j] = gelu_tanh(v0[j]); v1[j] = gelu_tanh(v1[j]); }
                    } else if (kind == 2) {
#pragma unroll
                        for (int j = 0; j < 4; ++j) { v0[j] = fsigmoid(v0[j]); v1[j] = fsigmoid(v1[j]); }
                    }
#ifdef P1_NT
                    if (kind == 1) __builtin_nontemporal_store(pack8(v0, v1), (GAS u32x4*)(GG + cg_index(row, col0 + bj * 128 - COL_GATE)));
                    else __builtin_nontemporal_store(pack8(v0, v1), (GAS u32x4*)(Z + (size_t)row * INW + col0 + bj * 128));
#else
                    if (kind == 1) st16(GG + cg_index(row, col0 + bj * 128 - COL_GATE), pack8(v0, v1));
                    else st16(Z + (size_t)row * INW + col0 + bj * 128, pack8(v0, v1));
#endif
                }
            }
    }
};

typedef ProbInProjT<0> ProbInProj;

constexpr float X8_SCALE = 8.0f;
constexpr int PN_GA = PN8_FIRST, COL8 = PN8_FIRST * 256, NCOL8 = INW - COL8;
struct ProbInProj8 {
    static constexpr bool FP8 = true, GATHER = false;
    typedef g8::Unit2 Unit;
    const unsigned char *XQ, *W8; const float* rstd; const float* bias; bf16_t* Z; bf16_t* GG; DynOrder8 D;
    __device__ __forceinline__ bool next(int i, Unit& u) const { return D.next(i, u); }
    __device__ __forceinline__ bool keep_acc(const Unit&) const { return false; }
    __device__ __forceinline__ int ntiles(const Unit&) const { return DM / 128; }
    __device__ __forceinline__ void setup(const Unit& u, int tid, g8::Rsrc& ra, g8::Rsrc& rb, int& db, unsigned (&o)[1], unsigned& vb, int& a64, int& b64) const {
        vb = g8::voff_b(tid, DM); a64 = 64 * DM; b64 = 64 * DM;
        ra = g8::mk_rsrc((const char*)XQ + (size_t)u.pm * 256 * DM);
        { int tz = tid; asm volatile("" : "+v"(tz)); int R, C; g8::stage_rc(tz * 16, R, C); o[0] = (unsigned)(R * DM + C * 2); }
        rb = g8::mk_rsrc((const char*)W8 + (size_t)(u.pn - PN_GA) * 256 * DM); db = 128 * DM;
    }
    __device__ __forceinline__ void epi(Acc& acc, const Unit& u, int wr, int wc, int fr, int fq) const {
        const int colt = u.pn * 256; const int row0 = u.pm * 256 + wr * 64 + fr, col0 = colt + wc * 32 + 8 * fq;
        const int kind = colt < COL_GATE ? 0 : (colt < COL_GA ? 1 : 2);
        f32x4 bv[2][2];
#pragma unroll
        for (int bj = 0; bj < 2; ++bj) { bv[bj][0] = ld4(bias + col0 + bj * 128); bv[bj][1] = ld4(bias + col0 + bj * 128 + 4); }
        float rsv[8];
#pragma unroll
        for (int q = 0; q < 8; ++q) rsv[q] = rstd[row0 + (q >> 2) * 128 + (q & 3) * 16] * (1.0f / (X8_SCALE * W8_SCALE));
#pragma unroll
        for (int ai = 0; ai < 2; ++ai)
#pragma unroll
            for (int m = 0; m < 4; ++m) {
                const int row = row0 + ai * 128 + m * 16; const float rs = rsv[ai * 4 + m];
#pragma unroll
                for (int bj = 0; bj < 2; ++bj) {
                    f32x4 v0 = acc[ai][bj][m][0] * rs + bv[bj][0], v1 = acc[ai][bj][m][1] * rs + bv[bj][1];
                    if (colt < COL_K) { v0 *= QK_SCALE; v1 *= QK_SCALE; }
                    if (kind == 1) {
#pragma unroll
                        for (int j = 0; j < 4; ++j) { v0[j] = gelu_tanh(v0[j]); v1[j] = gelu_tanh(v1[j]); }
                    } else if (kind == 2) {
#pragma unroll
                        for (int j = 0; j < 4; ++j) { v0[j] = fsigmoid(v0[j]); v1[j] = fsigmoid(v1[j]); }
                    }
                    if (kind == 1) st16(GG + cg_index(row, col0 + bj * 128 - COL_GATE), pack8(v0, v1));
                    else st16(Z + (size_t)row * INW + col0 + bj * 128, pack8(v0, v1));
                }
            }
    }
};

struct UnitG { int pm, n, ch; };
struct ProbGates {
    static constexpr int K = 256, LDBB = 512, LDAB = DM * 2;
    static constexpr bool FP8 = false, GATHER = false;
    typedef UnitG Unit;
    __device__ __forceinline__ bool keep_acc(const Unit&) const { return false; }
    int G, c; const bf16_t* UC; const bf16_t* W; const float *b_a, *b_x, *lam; bf16_t* LA2; bf16_t* XIN;
    __device__ __forceinline__ bool next(int i, Unit& u) const { const int L = i * G + c; if (L >= 1024) return false; u.ch = L & 1; u.n = (L >> 1) & 7; u.pm = L >> 4; return true; }
    __device__ __forceinline__ int ntiles(const Unit&) const { return K * 2 / 128; }
    __device__ __forceinline__ void setup(const Unit& u, int tid, g8::Rsrc& ra, g8::Rsrc& rb, int& db, unsigned (&o)[1], unsigned& vb, int& a64, int& b64) const {
        vb = g8::voff_b(tid, LDBB); a64 = 64 * LDAB; b64 = 64 * LDBB;
        ra = g8::mk_rsrc((const char*)UC + ((size_t)u.pm * 256 * DM + u.n * 256) * 2);
        { int tz = tid; asm volatile("" : "+v"(tz)); int R, C; g8::stage_rc(tz * 16, R, C); o[0] = (unsigned)(R * DM + C) * 2u; }
        rb = g8::mk_rsrc((const char*)W + ((size_t)(u.n * 256 + u.ch * 128) * 256) * 2); db = 8 * 256 * 256 * 2;
    }
    __device__ __forceinline__ void epi(Acc& acc, const Unit& u, int wr, int wc, int fr, int fq) const {
        const int ch0 = u.n * 256 + u.ch * 128 + wc * 32 + 8 * fq;
        const int row0 = u.pm * 256 + wr * 64 + fr;
        f32x4 ba[2], bx[2], sp[2];
#pragma unroll
        for (int n = 0; n < 2; ++n) { ba[n] = ld4(b_a + ch0 + 4 * n); bx[n] = ld4(b_x + ch0 + 4 * n); const f32x4 l = ld4(lam + ch0 + 4 * n);
#pragma unroll
            for (int j = 0; j < 4; ++j) { const float z = -l[j]; sp[n][j] = (z > 15.f) ? z : log1pf(__expf(z)); } }
        u32x4 ucv[8];
#pragma unroll
        for (int q = 0; q < 8; ++q) ucv[q] = ld16(UC + (size_t)(row0 + (q >> 2) * 128 + (q & 3) * 16) * DM + ch0);
#pragma unroll
        for (int ai = 0; ai < 2; ++ai)
#pragma unroll
            for (int m = 0; m < 4; ++m) {
                const int row = row0 + ai * 128 + m * 16; const bool first = (row & (SEQ - 1)) == 0;
                f32x4 uc0, uc1; unpack8(ucv[ai * 4 + m], uc0, uc1);
                f32x4 av[2], xv[2];
#pragma unroll
                for (int n = 0; n < 2; ++n)
#pragma unroll
                    for (int j = 0; j < 4; ++j) {
                        const float ea = 1.0f + __builtin_amdgcn_exp2f(-1.4426950409f * (acc[ai][0][m][n][j] + ba[n][j])), ex = 1.0f + __builtin_amdgcn_exp2f(-1.4426950409f * (acc[ai][1][m][n][j] + bx[n][j]));
                        const float tt = __builtin_amdgcn_rcpf(ea * ex); const float r = tt * ex, ig = tt * ea;
                        const float la = -8.0f * r * sp[n][j];
                        const float x2 = 2.0f * la; const float em = (x2 > -0.5f) ? -x2 * (1.0f + x2 * (0.5f + x2 * (0.16666667f + x2 * (0.041666668f + x2 * (0.0083333338f + x2 * 0.0013888889f))))) : 1.0f - __expf(x2);
                        const float mult = first ? 1.0f : __builtin_amdgcn_sqrtf(em);
                        av[n][j] = la * 1.4426950409f; xv[n][j] = mult * ig * (n == 0 ? uc0[j] : uc1[j]);
                    }
                const size_t o = cg_index(row, ch0);
                st16(LA2 + o, pack8(av[0], av[1])); st16(XIN + o, pack8(xv[0], xv[1]));
                __builtin_amdgcn_sched_barrier(0);
            }
    }
};

struct UnitP { int pm, pn, part; };
struct ProbProj2 {
    static constexpr int K = DM, LDBB = DM, LDAB = DM;
    static constexpr bool FP8 = true, GATHER = false;
    typedef UnitP Unit;
    g8::StaticOrder S; const bf16_t *YA, *YL, *WA, *WL, *Z; bf16_t* MG;
    __device__ __forceinline__ bool next(int i, Unit& u) const { g8::Unit2 t; if (!S.next(i >> 1, t)) return false; u.pm = t.pm; u.pn = t.pn; u.part = i & 1; return true; }
    __device__ __forceinline__ bool keep_acc(const Unit& u) const { return u.part == 0; }
    __device__ __forceinline__ int ntiles(const Unit&) const { return K / 128; }
    __device__ __forceinline__ void setup(const Unit& u, int tid, g8::Rsrc& ra, g8::Rsrc& rb, int& db, unsigned (&o)[1], unsigned& vb, int& a64, int& b64) const {
        vb = g8::voff_b(tid, LDBB); a64 = 64 * LDAB; b64 = 64 * LDBB;
        ra = g8::mk_rsrc((const char*)(u.part ? YL : YA) + (size_t)u.pm * 256 * DM);
        { int tz = tid; asm volatile("" : "+v"(tz)); int R, C; g8::stage_rc(tz * 16, R, C); o[0] = (unsigned)(R * DM + C * 2); }
        rb = g8::mk_rsrc((const char*)(u.part ? WL : WA) + (size_t)u.pn * 256 * DM); db = 128 * DM;
    }
    __device__ __forceinline__ void epi(Acc& acc, const Unit& u, int wr, int wc, int fr, int fq) const {
        const int row0 = u.pm * 256 + wr * 64 + fr, col0 = u.pn * 256 + wc * 32 + 8 * fq;
        if (u.part == 0) {
#pragma unroll
            for (int ai = 0; ai < 2; ++ai)
#pragma unroll
                for (int m = 0; m < 4; ++m) {
                    const int row = row0 + ai * 128 + m * 16;
#pragma unroll
                    for (int bj = 0; bj < 2; ++bj) {
                        const int col = col0 + bj * 128;
                        f32x4 l0, l1, a0, a1; unpack8(ld16(Z + (size_t)row * INW + COL_GL + col), l0, l1); unpack8(ld16(Z + (size_t)row * INW + COL_GA + col), a0, a1);
#pragma unroll
                        for (int j = 0; j < 4; ++j) { acc[ai][bj][m][0][j] *= a0[j] * __builtin_amdgcn_rcpf(l0[j]); acc[ai][bj][m][1][j] *= a1[j] * __builtin_amdgcn_rcpf(l1[j]); }
                    }
                }
        } else {
            u32x4 gl[8][2];
#pragma unroll
            for (int q = 0; q < 8; ++q)
#pragma unroll
                for (int bj = 0; bj < 2; ++bj) gl[q][bj] = ld16(Z + (size_t)(row0 + (q >> 2) * 128 + (q & 3) * 16) * INW + COL_GL + col0 + bj * 128);
#pragma unroll
            for (int ai = 0; ai < 2; ++ai)
#pragma unroll
                for (int m = 0; m < 4; ++m) {
                    const int row = row0 + ai * 128 + m * 16;
#pragma unroll
                    for (int bj = 0; bj < 2; ++bj) { f32x4 l0, l1; unpack8(gl[ai * 4 + m][bj], l0, l1);
                        st8((unsigned char*)MG + (size_t)row * DM + col0 + bj * 128, pack8_fp8(acc[ai][bj][m][0] * (l0 * (MG8_SCALE / (Y8_SCALE * W8_SCALE))), acc[ai][bj][m][1] * (l1 * (MG8_SCALE / (Y8_SCALE * W8_SCALE))))); }
                }
        }
    }
};

struct ProbOut {
    static constexpr bool FP8 = true, GATHER = false;
    typedef g8::Unit2 Unit;
    g8::StaticOrder S; const bf16_t* A; const bf16_t* Bt;
    __device__ __forceinline__ bool next(int i, Unit& u) const { return S.next(i, u); }
    __device__ __forceinline__ bool keep_acc(const Unit&) const { return false; }
    __device__ __forceinline__ int ntiles(const Unit&) const { return DM / 128; }
    __device__ __forceinline__ void setup(const Unit& u, int tid, g8::Rsrc& ra, g8::Rsrc& rb, int& db, unsigned (&o)[1], unsigned& vb, int& a64, int& b64) const {
        vb = g8::voff_b(tid, DM); a64 = 64 * DM; b64 = 64 * DM;
        ra = g8::mk_rsrc((const char*)A + (size_t)u.pm * 256 * DM);
        { int tz = tid; asm volatile("" : "+v"(tz)); int R, C; g8::stage_rc(tz * 16, R, C); o[0] = (unsigned)(R * DM + C * 2); }
        rb = g8::mk_rsrc((const char*)Bt + (size_t)u.pn * 256 * DM); db = 128 * DM;
    }
    const float* X; float* H1; unsigned char* H1Q;
    __device__ __forceinline__ void epi(Acc& acc, const Unit& u, int wr, int wc, int fr, int fq) const {
        const int row0 = u.pm * 256 + wr * 64 + fr, col0 = u.pn * 256 + wc * 32 + 8 * fq;
        f32x4 xn[4];
#pragma unroll
        for (int t = 0; t < 4; ++t) xn[t] = ld4(X + (size_t)row0 * DM + col0 + (t >> 1) * 128 + (t & 1) * 4);
#pragma unroll
        for (int q = 0; q < 8; ++q) {
            const int ai = q >> 2, m = q & 3; const int row = row0 + ai * 128 + m * 16;
            f32x4 xc[4];
#pragma unroll
            for (int t = 0; t < 4; ++t) xc[t] = xn[t];
            if (q < 7) { const int rn = row0 + ((q + 1) >> 2) * 128 + ((q + 1) & 3) * 16;
#pragma unroll
                for (int t = 0; t < 4; ++t) xn[t] = ld4(X + (size_t)rn * DM + col0 + (t >> 1) * 128 + (t & 1) * 4); }
#pragma unroll
            for (int bj = 0; bj < 2; ++bj) {
                const size_t o = (size_t)row * DM + col0 + bj * 128;
                const f32x4 v0 = acc[ai][bj][m][0] * (1.0f / (MG8_SCALE * W8_SCALE)) + xc[2 * bj], v1 = acc[ai][bj][m][1] * (1.0f / (MG8_SCALE * W8_SCALE)) + xc[2 * bj + 1];
                st4(H1 + o, v0); st4(H1 + o + 4, v1); st8(H1Q + o, pack8_fp8(v0, v1));
            }
        }
    }
};

struct UnitM { int e, rt, ct, cnt, base; };
template <int NCT_LOG2>
__device__ __forceinline__ bool moe_next(const volatile LAS int* tab, int i, int G, int c, UnitM& u) {
    int ct, g;
    if (G == 256) { const int x = c & 7, j = c >> 3;
        if (NCT_LOG2 == 4) { ct = 4 * (x & 3) + (j & 3); g = i * 16 + 8 * (x >> 2) + (j >> 2); }
        else { ct = 4 * (x & 1) + (j & 3); g = i * 32 + 8 * (x >> 1) + (j >> 2); } }
    else { const int L = i * G + c; ct = L & ((1 << NCT_LOG2) - 1); g = L >> NCT_LOG2; }
    if (g >= __builtin_amdgcn_readfirstlane(tab[32])) return false;
    const int e = __builtin_amdgcn_readfirstlane((int)((const volatile LAS unsigned char*)tab)[576 + g]);
    u.e = e; u.rt = g - __builtin_amdgcn_readfirstlane(tab[e]); u.ct = ct; u.base = __builtin_amdgcn_readfirstlane(tab[33 + e]); u.cnt = __builtin_amdgcn_readfirstlane(tab[33 + e + 1]) - u.base; return true;
}
struct ProbMoe1 {
    static constexpr int K = DM, LDBB = DM, LDAB = DM;
    static constexpr bool FP8 = true, GATHER = true;
    typedef UnitM Unit;
    __device__ __forceinline__ bool keep_acc(const Unit&) const { return false; }
    int G, c; const volatile LAS int* tab; const unsigned char* H1Q; const unsigned char* W1; const int* elist; const float* rstd2; const float* prs; const float* b1; unsigned char* ACT;
    __device__ __forceinline__ bool next(int i, Unit& u) const { return moe_next<4>(tab, i, G, c, u); }
    __device__ __forceinline__ int ntiles(const Unit&) const { return K / 128; }
    __device__ __forceinline__ void setup(const Unit& u, int tid, g8::Rsrc& ra, g8::Rsrc& rb, int& db, unsigned (&o)[4], unsigned& vb, int& a64, int& b64) const {
        vb = g8::voff_b(tid, LDBB); a64 = 64 * LDAB; b64 = 64 * LDBB;
        ra = g8::mk_rsrc(H1Q); const int* el = elist + (size_t)u.e * NTOK;
        int tz = tid; asm volatile("" : "+v"(tz));
        int R, C; g8::stage_rc(tz * 16, R, C);
#pragma unroll
        for (int q = 0; q < 4; ++q) { const int pq = u.rt * 256 + R + 64 * (q & 1) + 128 * (q >> 1); const int sq = el[pq < u.cnt ? pq : 0] & 0xffff; o[q] = (unsigned)((sq >> 2) * DM + C * 2); }
        rb = g8::mk_rsrc((const char*)W1 + ((size_t)u.e * 2 * DFF + u.ct * 128) * DM); db = DFF * DM;
    }
    __device__ __forceinline__ void epi(Acc& acc, const Unit& u, int wr, int wc, int fr, int fq) const {
        const int gc = u.ct * 128 + wc * 32 + 8 * fq; const float* bb = b1 + (size_t)u.e * 2 * DFF;
        const f32x4 bg0 = ld4(bb + gc), bg1 = ld4(bb + gc + 4), bl0 = ld4(bb + DFF + gc), bl1 = ld4(bb + DFF + gc + 4);
        const int* el = elist + (size_t)u.e * NTOK;
#pragma unroll
        for (int ai = 0; ai < 2; ++ai) {
            float rsv[4];
#pragma unroll
            for (int q = 0; q < 4; ++q) { const int pos = u.rt * 256 + ai * 128 + wr * 64 + q * 16 + fr; rsv[q] = prs[(size_t)u.e * NTOK + (pos < u.cnt ? pos : 0)] * (1.0f / W8_SCALE); }
#pragma unroll
            for (int m = 0; m < 4; ++m) {
                const int pos = u.rt * 256 + ai * 128 + wr * 64 + m * 16 + fr; const float rs = rsv[m];
                f32x4 g0 = acc[ai][0][m][0] * rs + bg0, g1 = acc[ai][0][m][1] * rs + bg1, l0 = acc[ai][1][m][0] * rs + bl0, l1 = acc[ai][1][m][1] * rs + bl1;
#pragma unroll
                for (int j = 0; j < 4; ++j) {
                    float g = fminf(g0[j], 7.0f), l = fminf(fmaxf(l0[j], -7.0f), 7.0f); g0[j] = g * fsigmoid(1.702f * g) * (l + 1.0f) * ACT8_SCALE;
                    g = fminf(g1[j], 7.0f); l = fminf(fmaxf(l1[j], -7.0f), 7.0f); g1[j] = g * fsigmoid(1.702f * g) * (l + 1.0f) * ACT8_SCALE;
                }
                if (pos < u.cnt) st8(ACT + (size_t)(u.base + pos) * DFF + gc, pack8_fp8(g0, g1));
            }
        }
    }
};
template <int STUB> struct ProbMoe2T {
    static constexpr int K = DFF, LDBB = DFF, LDAB = DFF;
    static constexpr bool FP8 = true, GATHER = false;
    typedef UnitM Unit;
    __device__ __forceinline__ bool keep_acc(const Unit&) const { return false; }
    int G, c; const volatile LAS int* tab; const unsigned char* ACT; const unsigned char* W2; const int* elist; const float* topw; const float* pw; const float* b2; unsigned char* YB;
    __device__ __forceinline__ bool next(int i, Unit& u) const { return moe_next<3>(tab, i, G, c, u); }
    __device__ __forceinline__ int ntiles(const Unit&) const { return K / 128; }
    __device__ __forceinline__ void setup(const Unit& u, int tid, g8::Rsrc& ra, g8::Rsrc& rb, int& db, unsigned (&o)[1], unsigned& vb, int& a64, int& b64) const {
        vb = g8::voff_b(tid, LDBB); a64 = 64 * LDAB; b64 = 64 * LDBB;
        ra = g8::mk_rsrc((const char*)ACT + (size_t)(u.base + u.rt * 256) * DFF);
        { int tz = tid; asm volatile("" : "+v"(tz)); int R, C; g8::stage_rc(tz * 16, R, C); o[0] = (unsigned)(R * DFF + C * 2); }
        rb = g8::mk_rsrc((const char*)W2 + ((size_t)u.e * DM + u.ct * 256) * DFF); db = 128 * DFF;
    }
    __device__ __forceinline__ void epi(Acc& acc, const Unit& u, int wr, int wc, int fr, int fq) const {
        if (STUB) { f32x4 t = {0.f, 0.f, 0.f, 0.f};
#pragma unroll
            for (int a_ = 0; a_ < 2; ++a_)
#pragma unroll
                for (int b_ = 0; b_ < 2; ++b_)
#pragma unroll
                    for (int m_ = 0; m_ < 4; ++m_)
#pragma unroll
                        for (int n_ = 0; n_ < 2; ++n_) t += acc[a_][b_][m_][n_];
            if (t[0] + t[1] + t[2] + t[3] == 1.2345e30f) YB[0] = 1; return; }
        const int col0 = u.ct * 256 + wc * 32 + 8 * fq; const float* bb = b2 + (size_t)u.e * DM;
        f32x4 bv[2][2];
#pragma unroll
        for (int bj = 0; bj < 2; ++bj) { bv[bj][0] = ld4(bb + col0 + bj * 128); bv[bj][1] = ld4(bb + col0 + bj * 128 + 4); }
        const int* el = elist + (size_t)u.e * NTOK;
#pragma unroll
        for (int ai = 0; ai < 2; ++ai) {
            int slot[4]; float wv[4];
#pragma unroll
            for (int q = 0; q < 4; ++q) { const int pos = u.rt * 256 + ai * 128 + wr * 64 + q * 16 + fr; slot[q] = el[pos < u.cnt ? pos : 0] & 0xffff; }
#pragma unroll
            for (int q = 0; q < 4; ++q) { const int pos = u.rt * 256 + ai * 128 + wr * 64 + q * 16 + fr; wv[q] = pw[(size_t)u.e * NTOK + (pos < u.cnt ? pos : 0)] * YB8_SCALE; }
#pragma unroll
            for (int m = 0; m < 4; ++m) {
                const int pos = u.rt * 256 + ai * 128 + wr * 64 + m * 16 + fr; const float w = wv[m]; const int sl = slot[m];
                if (pos < u.cnt) {
#pragma unroll
                    for (int bj = 0; bj < 2; ++bj)
                        st8(YB + (size_t)sl * DM + col0 + bj * 128, pack8_fp8((acc[ai][bj][m][0] * (1.0f / (W8_SCALE * ACT8_SCALE)) + bv[bj][0]) * w, (acc[ai][bj][m][1] * (1.0f / (W8_SCALE * ACT8_SCALE)) + bv[bj][1]) * w));
                }
            }
        }
    }
};
typedef ProbMoe2T<0> ProbMoe2;

struct ProbPle : g8::DenseBase<PLE, PLE, PLE> {
    bf16_t* PE;
    __device__ __forceinline__ void epi(Acc& acc, const Unit& u, int wr, int wc, int fr, int fq) const {
        const int row0 = u.pm * 256 + wr * 64 + fr, col0 = u.pn * 256 + wc * 32 + 8 * fq;
#pragma unroll
        for (int ai = 0; ai < 2; ++ai)
#pragma unroll
            for (int m = 0; m < 4; ++m)
#pragma unroll
                for (int bj = 0; bj < 2; ++bj) st16(PE + (size_t)(row0 + ai * 128 + m * 16) * DM + col0 + bj * 128, pack8(acc[ai][bj][m][0], acc[ai][bj][m][1]));
    }
};
struct ProbGate8 {
    static constexpr bool FP8 = true, GATHER = false;
    typedef g8::Unit2 Unit;
    g8::StaticOrder S; const unsigned char *H2Q, *WPG8; const bf16_t *H2B, *PE; const float* rstd3; bf16_t* H3B; float* SS3;
    __device__ __forceinline__ bool next(int i, Unit& u) const { return S.next(i, u); }
    __device__ __forceinline__ bool keep_acc(const Unit&) const { return false; }
    __device__ __forceinline__ int ntiles(const Unit&) const { return DM / 128; }
    __device__ __forceinline__ void setup(const Unit& u, int tid, g8::Rsrc& ra, g8::Rsrc& rb, int& db, unsigned (&o)[1], unsigned& vb, int& a64, int& b64) const {
        vb = g8::voff_b(tid, DM); a64 = 64 * DM; b64 = 64 * DM;
        ra = g8::mk_rsrc((const char*)H2Q + (size_t)u.pm * 256 * DM);
        { int tz = tid; asm volatile("" : "+v"(tz)); int R, C; g8::stage_rc(tz * 16, R, C); o[0] = (unsigned)(R * DM + C * 2); }
        rb = g8::mk_rsrc((const char*)WPG8 + (size_t)u.pn * 256 * DM); db = 128 * DM;
    }
    __device__ __forceinline__ void epi(Acc& acc, const Unit& u, int wr, int wc, int fr, int fq) const {
        const int row0 = u.pm * 256 + wr * 64 + fr, col0 = u.pn * 256 + wc * 32 + 8 * fq;
        float rsv[8];
#pragma unroll
        for (int q = 0; q < 8; ++q) rsv[q] = rstd3[row0 + (q >> 2) * 128 + (q & 3) * 16] * (1.0f / W8_SCALE);
        u32x4 pn[2], hn[2];
#pragma unroll
        for (int bj = 0; bj < 2; ++bj) { const size_t o = (size_t)row0 * DM + col0 + bj * 128; pn[bj] = ld16(PE + o); hn[bj] = ld16(H2B + o); }
#pragma unroll
        for (int q = 0; q < 8; ++q) {
            const int ai = q >> 2, m = q & 3; const int row = row0 + ai * 128 + m * 16; const float rs = rsv[q];
            u32x4 pc[2], hc[2];
#pragma unroll
            for (int t = 0; t < 2; ++t) { pc[t] = pn[t]; hc[t] = hn[t]; }
            if (q < 7) { const int rn = row0 + ((q + 1) >> 2) * 128 + ((q + 1) & 3) * 16;
#pragma unroll
                for (int bj = 0; bj < 2; ++bj) { const size_t o = (size_t)rn * DM + col0 + bj * 128; pn[bj] = ld16(PE + o); hn[bj] = ld16(H2B + o); } }
            float ss = 0.f;
#pragma unroll
            for (int bj = 0; bj < 2; ++bj) {
                const size_t o = (size_t)row * DM + col0 + bj * 128;
                f32x4 pe[2], h[2], v[2]; unpack8(pc[bj], pe[0], pe[1]); unpack8(hc[bj], h[0], h[1]);
#pragma unroll
                for (int n = 0; n < 2; ++n)
#pragma unroll
                    for (int j = 0; j < 4; ++j) { v[n][j] = h[n][j] + fsigmoid(acc[ai][bj][m][n][j] * rs) * pe[n][j]; ss += v[n][j] * v[n][j]; }
                st16(H3B + o, pack8(v[0], v[1]));
            }
            ss += __shfl_xor(ss, 16); ss += __shfl_xor(ss, 32);
            if (fq == 0) SS3[(size_t)row * 32 + u.pn * 4 + wc] = ss;
        }
    }
};

__device__ __forceinline__ void tr_item(const float* W, int N, bf16_t* WT, int K, const float* scale, int kb, int nb, LAS float* scr, int lane) {
    const int k0 = kb * 64, n0 = nb * 64, lr = lane >> 4, lc = (lane & 15) * 4;
    f32x4 v[16];
#pragma unroll
    for (int i = 0; i < 16; ++i) v[i] = __builtin_nontemporal_load((const GAS f32x4*)(W + (size_t)(k0 + 4 * i + lr) * N + n0 + lc));
#pragma unroll
    for (int i = 0; i < 16; ++i) { const int kk = 4 * i + lr; const float sc = scale ? scale[k0 + kk] : 1.0f;
        scr[kk * 65 + lc + 0] = v[i][0] * sc; scr[kk * 65 + lc + 1] = v[i][1] * sc; scr[kk * 65 + lc + 2] = v[i][2] * sc; scr[kk * 65 + lc + 3] = v[i][3] * sc; }
    LDS_WAIT();
    const int c = lane & 7;
#pragma unroll
    for (int j = 0; j < 8; ++j) { const int n = (lane >> 3) + 8 * j; const LAS float* s = scr + (8 * c) * 65 + n;
        u32x4 o; o.x = pk2(s[0 * 65], s[1 * 65]); o.y = pk2(s[2 * 65], s[3 * 65]); o.z = pk2(s[4 * 65], s[5 * 65]); o.w = pk2(s[6 * 65], s[7 * 65]);
        st16(WT + (size_t)(n0 + n) * K + k0 + 8 * c, o); }
    LDS_WAIT();
}

struct TrJob { const float* W; unsigned char* WQ; const float* scale; int N, K, kb, nb; };
struct TrRegs { f32x4 v[16]; float sc[16]; };
__device__ __forceinline__ void tr8_load(const TrJob& j, TrRegs& r, float mul, int lane) {
    const int k0 = j.kb * 128, n0 = j.nb * 32, lr = lane >> 3, lc = (lane & 7) * 4;
#pragma unroll
    for (int i = 0; i < 16; ++i) r.sc[i] = j.scale ? j.scale[k0 + 8 * i + lr] * mul : mul;
#pragma unroll
#ifdef CONV_PLAIN_LD
    for (int i = 0; i < 16; ++i) r.v[i] = *(const GAS f32x4*)(j.W + (size_t)(k0 + 8 * i + lr) * j.N + n0 + lc);
#else
    for (int i = 0; i < 16; ++i) r.v[i] = __builtin_nontemporal_load((const GAS f32x4*)(j.W + (size_t)(k0 + 8 * i + lr) * j.N + n0 + lc));
#endif
}
__device__ __forceinline__ void tr8_finish(const TrJob& j, const TrRegs& r, LAS float* scr, int lane) {
    const int k0 = j.kb * 128, n0 = j.nb * 32, lr = lane >> 3, lc = (lane & 7) * 4;
#pragma unroll
    for (int i = 0; i < 16; ++i) { const int kk = 8 * i + lr; const f32x4 t = r.v[i] * r.sc[i];
        scr[(lc + 0) * 130 + kk] = t[0]; scr[(lc + 1) * 130 + kk] = t[1]; scr[(lc + 2) * 130 + kk] = t[2]; scr[(lc + 3) * 130 + kk] = t[3]; }
    LDS_WAIT();
    const int c = lane & 7;
#pragma unroll
    for (int jj = 0; jj < 4; ++jj) { const int n = (lane >> 3) + 8 * jj; const LAS f32x2* sp = (const LAS f32x2*)(scr + n * 130 + 16 * c);
        u32x4 o;
#pragma unroll
        for (int q = 0; q < 4; ++q) { const f32x2 p0 = sp[2 * q], p1 = sp[2 * q + 1]; int w = 0; w = __builtin_amdgcn_cvt_pk_fp8_f32(p0[0], p0[1], w, false); w = __builtin_amdgcn_cvt_pk_fp8_f32(p1[0], p1[1], w, true); o[q] = (unsigned)w; }
        __builtin_nontemporal_store(o, (GAS u32x4*)(j.WQ + (size_t)(n0 + n) * j.K + k0 + 16 * c)); }
    LDS_WAIT();
}
constexpr int I_W1 = 32 * 16 * 128, I_W2 = 32 * 16 * 64, I_MOE = I_W1 + I_W2;
__device__ __forceinline__ TrJob moe_job(const float* w1, const float* w2, const float* gffn, unsigned char* ws, int it) {
    TrJob j;
    if (it < I_W1) { const int e = it >> 11, q = it & 2047; j.W = w1 + (size_t)e * DM * 2 * DFF; j.N = 2 * DFF; j.WQ = ws + WS_W1 + (size_t)e * 2 * DFF * DM; j.K = DM; j.scale = gffn; j.kb = q >> 7; j.nb = q & 127; }
    else { const int r = it - I_W1, e = r >> 10, q = r & 1023; j.W = w2 + (size_t)e * DFF * DM; j.N = DM; j.WQ = ws + WS_W2 + (size_t)e * DM * DFF; j.K = DFF; j.scale = nullptr; j.kb = q >> 6; j.nb = q & 63; }
    return j;
}
constexpr int NB_W1 = 32 * 16 * 32, NB_W2 = 32 * 16 * 16, NB_MOE = NB_W1 + NB_W2;
struct BlkJob { const float* W; unsigned char* WQ; const float* scale; int N, K, kb, nb, use_scale; };
constexpr int NB_PG = 16 * 16, NB_ALL = NB_MOE + 4 * NB_PG, NB_IN8 = 16 * ((INW - PN8_FIRST * 256) / 128);
__device__ __forceinline__ BlkJob moe_blk(const float* w1, const float* w2, const float* gffn, unsigned char* ws, int it, const float* wpg, const float* gple, const float* win, const float* gmix, const float* wap, const float* wlp, const float* wout) {
    BlkJob j;
    if (it >= NB_ALL) { const int q = it - NB_ALL; constexpr int NNB = (INW - PN8_FIRST * 256) / 128; j.W = win + PN8_FIRST * 256; j.N = INW; j.WQ = ws + WS_WIN8; j.K = DM; j.scale = gmix; j.use_scale = 1; j.kb = q / NNB; j.nb = q % NNB; }
    else if (it >= NB_MOE + 3 * NB_PG) { const int q = it - NB_MOE - 3 * NB_PG; j.W = wout; j.N = DM; j.WQ = ws + WS_WOUT; j.K = DM; j.scale = gple; j.use_scale = 0; j.kb = q >> 4; j.nb = q & 15; }
    else if (it >= NB_MOE + 2 * NB_PG) { const int q = it - NB_MOE - 2 * NB_PG; j.W = wlp; j.N = DM; j.WQ = ws + WS_WLP; j.K = DM; j.scale = gple; j.use_scale = 0; j.kb = q >> 4; j.nb = q & 15; }
    else if (it >= NB_MOE + NB_PG) { const int q = it - NB_MOE - NB_PG; j.W = wap; j.N = DM; j.WQ = ws + WS_WAP; j.K = DM; j.scale = gple; j.use_scale = 0; j.kb = q >> 4; j.nb = q & 15; }
    else if (it >= NB_MOE) { const int q = it - NB_MOE; j.W = wpg; j.N = DM; j.WQ = ws + WS_WPG; j.K = DM; j.scale = gple; j.use_scale = 1; j.kb = q >> 4; j.nb = q & 15; }
    else if (it < NB_W1) { const int e = it >> 9, q = it & 511; j.W = w1 + (size_t)e * DM * 2 * DFF; j.N = 2 * DFF; j.WQ = ws + WS_W1 + (size_t)e * 2 * DFF * DM; j.K = DM; j.scale = gffn; j.use_scale = 1; j.kb = q >> 5; j.nb = q & 31; }
    else { const int r = it - NB_W1, e = r >> 8, q = r & 255; j.W = w2 + (size_t)e * DFF * DM; j.N = DM; j.WQ = ws + WS_W2 + (size_t)e * DM * DFF; j.K = DFF; j.scale = gffn; j.use_scale = 0; j.kb = q >> 4; j.nb = q & 15; }
    return j;
}
__device__ __forceinline__ void blk_load(const BlkJob& j, f32x4 (&v)[8], float (&sc)[8], int wave, int lane) {
    const int kr = 16 * wave + (lane >> 5), g = lane & 31;
#pragma unroll
    for (int i = 0; i < 8; ++i) { const float g = j.scale[j.kb * 128 + kr + 2 * i]; sc[i] = (j.use_scale ? g : 1.0f) * W8_SCALE; }
#pragma unroll
    for (int i = 0; i < 8; ++i) v[i] = __builtin_nontemporal_load((const GAS f32x4*)(j.W + (size_t)(j.kb * 128 + kr + 2 * i) * j.N + j.nb * 128 + 4 * g));
}
__device__ __forceinline__ void blk_put(const f32x4 (&v)[8], const float (&sc)[8], LAS float* buf, int wave, int lane) {
    const int kr = 16 * wave + (lane >> 5), g = lane & 31;
#pragma unroll
    for (int i = 0; i < 8; ++i) { const int k = kr + 2 * i; *(LAS f32x4*)(buf + k * 128 + 4 * (g ^ (k >> 4))) = v[i] * sc[i]; }
}
__device__ __forceinline__ void blk_emit(const BlkJob& cur, const LAS float* buf, int wave, int lane) {
    const int c = lane & 7;
#pragma unroll
    for (int jj = 0; jj < 2; ++jj) { const int nn = 16 * wave + (lane >> 3) + 8 * jj; const LAS float* sp = buf + (16 * c) * 128 + 4 * ((nn >> 2) ^ c) + (nn & 3);
        u32x4 o;
#pragma unroll
        for (int q = 0; q < 4; ++q) { int w = 0; w = __builtin_amdgcn_cvt_pk_fp8_f32(sp[(4 * q) * 128], sp[(4 * q + 1) * 128], w, false); w = __builtin_amdgcn_cvt_pk_fp8_f32(sp[(4 * q + 2) * 128], sp[(4 * q + 3) * 128], w, true); o[q] = (unsigned)w; }
        __builtin_nontemporal_store(o, (GAS u32x4*)(cur.WQ + (size_t)(cur.nb * 128 + nn) * cur.K + cur.kb * 128 + 16 * c)); }
}
__device__ __forceinline__ void moe_convert_blocks(const float* w1, const float* w2, const float* gffn, unsigned char* ws, int it0, int n, LAS unsigned char* lds, int wave, int lane, const float* wpg, const float* gple, const float* win, const float* gmix, const float* wap, const float* wlp, const float* wout) {
    if (n <= 0) return;
    const int itl = it0 + n - 1;
    BlkJob j0 = moe_blk(w1, w2, gffn, ws, it0, wpg, gple, win, gmix, wap, wlp, wout), j1 = moe_blk(w1, w2, gffn, ws, it0 + 1 < itl ? it0 + 1 : itl, wpg, gple, win, gmix, wap, wlp, wout);
    f32x4 v0[8], v1[8]; float s0[8], s1[8];
    blk_load(j0, v0, s0, wave, lane);
    blk_load(j1, v1, s1, wave, lane);
    LAS float* bufA = (LAS float*)lds; LAS float* bufB = (LAS float*)(lds + 65536);
#pragma unroll 1
    for (int b = 0; b < n; b += 2) {
        blk_put(v0, s0, bufA, wave, lane);
        __syncthreads();
        const BlkJob c0 = j0;
        { const int t = it0 + b + 2; j0 = moe_blk(w1, w2, gffn, ws, t < itl ? t : itl, wpg, gple, win, gmix, wap, wlp, wout); blk_load(j0, v0, s0, wave, lane); }
        blk_emit(c0, bufA, wave, lane);
        blk_put(v1, s1, bufB, wave, lane);
        __syncthreads();
        const BlkJob c1 = j1;
        { const int t = it0 + b + 3; j1 = moe_blk(w1, w2, gffn, ws, t < itl ? t : itl, wpg, gple, win, gmix, wap, wlp, wout); blk_load(j1, v1, s1, wave, lane); }
        blk_emit(c1, bufB, wave, lane);
    }
    __syncthreads();
}

struct Args { const float* in[27]; float* out; unsigned char* ws; int ph_lo, ph_hi; };

__device__ __forceinline__ void p0_prologue(const Args& a, LAS unsigned char* lds, int gw, int NGW, int lane, int wave) {
    unsigned char* ws = a.ws;
    LAS float* scr = (LAS float*)(lds + wave * 16896);
    constexpr int NB64 = PN8_FIRST * 4, I_IN = 32 * NB64, I_SQ = 32 * 32, I_PLE = 4 * 32, I_RG = 8 * 16, dummy_ = 0;
    constexpr int NIT = I_IN + 0 * I_SQ + I_PLE + 2 * I_RG; (void)I_SQ; (void)dummy_;
    for (int it = gw; it < NIT; it += NGW) {
        int r = it;
        if (NB64 > 0 && r < I_IN) { const int nb64 = NB64 > 0 ? NB64 : 1; tr_item(a.in[3], INW, (bf16_t*)(ws + WS_WIN), DM, a.in[2], r / nb64, r % nb64, scr, lane); continue; } r -= I_IN;
        if (r < I_PLE) { tr_item(a.in[24], DM, (bf16_t*)(ws + WS_WPLE), PLE, nullptr, r / 32, r % 32, scr, lane); continue; } r -= I_PLE;
        if (r < I_RG) { const int mtx = r >> 4, q = r & 15; tr_item(a.in[7] + (size_t)mtx * 65536, 256, (bf16_t*)(ws + WS_WRG) + (size_t)mtx * 65536, 256, nullptr, q >> 2, q & 3, scr, lane); continue; } r -= I_RG;
        { const int mtx = r >> 4, q = r & 15; tr_item(a.in[9] + (size_t)mtx * 65536, 256, (bf16_t*)(ws + WS_WRG) + (size_t)(8 + mtx) * 65536, 256, nullptr, q >> 2, q & 3, scr, lane); }
    }
    __syncthreads();
    { const int G = NGW / NWAVES, bxx = gw / NWAVES;
      const int per = (NB_IN8 + G - 1) / G, b0 = bxx * per; int n = per; if (b0 + n > NB_IN8) n = NB_IN8 - b0;
      moe_convert_blocks(a.in[19], a.in[21], a.in[16], ws, NB_ALL + b0, n, lds, wave, lane, a.in[25], a.in[23], a.in[3], a.in[2], a.in[13], a.in[14], a.in[15]); }
    const float* x = a.in[0]; bf16_t* XB = (bf16_t*)(ws + WS_XB); float* rstd1 = (float*)(ws + WS_RSTD1); unsigned char* XQ = ws + WS_H1Q;
    for (int m = gw; m < NTOK; m += NGW) {
        float ss = 0.f;
#pragma unroll
        for (int j = 0; j < 4; ++j) { const size_t o = (size_t)m * DM + j * 512 + lane * 8; const f32x4 v0 = ld4(x + o), v1 = ld4(x + o + 4);
            ss += (v0[0] * v0[0] + v0[1] * v0[1]) + (v0[2] * v0[2] + v0[3] * v0[3]) + (v1[0] * v1[0] + v1[1] * v1[1]) + (v1[2] * v1[2] + v1[3] * v1[3]);
            if (PN8_FIRST > 0) st16(XB + o, pack8(v0, v1));
            st8(XQ + o, pack8_fp8(v0 * X8_SCALE, v1 * X8_SCALE)); }
        ss = wave_sum(ss);
        if (lane == 0) rstd1[m] = 1.0f / sqrtf(ss * (1.0f / DM) + RMS_EPS);
    }
    const float* p = a.in[1]; bf16_t* PB = (bf16_t*)(ws + WS_PB);
    for (int i = gw * 64 + lane; i < NTOK * PLE / 8; i += NGW * 64) { const size_t o = (size_t)i * 8; st16(PB + o, pack8(ld4(p + o), ld4(p + o + 4))); }
    bf16_t* WRH = (bf16_t*)(ws + WS_WR); bf16_t* WRL = WRH + NEXP * DM;
    for (int i = gw * 64 + lane; i < NEXP * DM; i += NGW * 64) { const int e = i >> 11, k = i & 2047; const float v = a.in[17][(size_t)k * NEXP + e] * a.in[16][k];
        const unsigned h = pk2(v, 0.f) & 0xffffu; const float r = v - __uint_as_float(h << 16); WRH[i] = (bf16_t)h; WRL[i] = (bf16_t)(pk2(r, 0.f) & 0xffffu); }
}

constexpr int KS_PITCH = 80, VS_PITCH = 80, VS_OFF = 256 * KS_PITCH * 2;
typedef short v4i16_t __attribute__((ext_vector_type(4)));
__device__ __forceinline__ u32x2 vtr(const LAS bf16_t* p) { return __builtin_bit_cast(u32x2, __builtin_amdgcn_ds_read_tr16_b64_v4i16((LAS v4i16_t*)p)); }
template <bool ODD>
__device__ __forceinline__ void attn_qg(const LAS bf16_t* Ks, const LAS bf16_t* Vt, const bf16x8 q0, const bf16x8 q1, bf16_t* YA, int m_cur, int nbi, int h, float sink2, int fr, int fq, int dmask, int qg) {
    constexpr int WSKIP = ODD ? 0 : 9, WD = ODD ? 1 : 0, WU = ODD ? 9 : 8;
    f32x4 s[10];
    const int kt0 = qg - (ODD ? 1 : 0);
    int koff = fr * KS_PITCH + fq * 8 + kt0 * 16 * KS_PITCH, voff = (kt0 * 16 + 4 * fq + (fr >> 2)) * VS_PITCH + 4 * (fr & 3);
    asm volatile("" : "+v"(koff), "+v"(voff));
#pragma unroll
    for (int w = 0; w < 10; ++w) {
        if (w == WSKIP) { s[w] = (f32x4){0.f, 0.f, 0.f, 0.f}; continue; }
        const bf16x8 k0 = *(const LAS bf16x8*)(Ks + koff + w * 16 * KS_PITCH), k1 = *(const LAS bf16x8*)(Ks + koff + w * 16 * KS_PITCH + 32);
        f32x4 z = (f32x4){0.f, 0.f, 0.f, 0.f};
        z = __builtin_amdgcn_mfma_f32_16x16x32_bf16(k0, q0, z, 0, 0, 0);
        s[w] = __builtin_amdgcn_mfma_f32_16x16x32_bf16(k1, q1, z, 0, 0, 0);
    }
#pragma unroll
    for (int r = 0; r < 4; ++r) { const bool d = (dmask >> r) & 1; s[WD][r] = d ? s[WD][r] : -3.0e38f; s[WU][r] = d ? -3.0e38f : s[WU][r]; }
    if (nbi == 0) {
#pragma unroll
        for (int w = 0; w < 10; ++w)
#pragma unroll
            for (int r = 0; r < 4; ++r) if (w != WSKIP) s[w][r] = ((kt0 + w) * 16 + 4 * fq + r >= 128) ? s[w][r] : -3.0e38f;
    }
    float mx = sink2;
#pragma unroll
    for (int w = 0; w < 10; ++w) if (w != WSKIP) mx = fmaxf(fmaxf(mx, fmaxf(s[w][0], s[w][1])), fmaxf(s[w][2], s[w][3]));
    mx = fmaxf(mx, __shfl_xor(mx, 16)); mx = fmaxf(mx, __shfl_xor(mx, 32));
    float sum = 0.f;
#pragma unroll
    for (int w = 0; w < 10; ++w)
#pragma unroll
        for (int r = 0; r < 4; ++r) if (w != WSKIP) { const float pv = __builtin_amdgcn_exp2f(s[w][r] - mx); s[w][r] = pv; sum += pv; }
    sum += __shfl_xor(sum, 16); sum += __shfl_xor(sum, 32);
    sum += __builtin_amdgcn_exp2f(sink2 - mx);
    const float inv = __builtin_amdgcn_rcpf(sum);
    f32x4 o[4];
#pragma unroll
    for (int dt = 0; dt < 4; ++dt) o[dt] = (f32x4){0.f, 0.f, 0.f, 0.f};
#pragma unroll
    for (int i2 = 0; i2 < 5; ++i2) {
        union { u32x4 u; bf16x8 v; } pf; pf.u = pack8(s[2 * i2], s[2 * i2 + 1]);
#pragma unroll
        for (int dt = 0; dt < 4; ++dt) {
            const LAS bf16_t* vr = Vt + voff + dt * 16 + 32 * i2 * VS_PITCH;
            union { struct { u32x2 lo, hi; } h2; bf16x8 v; } vf; vf.h2.lo = vtr(vr); vf.h2.hi = vtr(vr + 16 * VS_PITCH);
            o[dt] = __builtin_amdgcn_mfma_f32_16x16x32_bf16(vf.v, pf.v, o[dt], 0, 0, 0);
        }
    }
    unsigned char* yo = (unsigned char*)YA + (size_t)(m_cur + qg * 16 + fr) * DM + h * 64 + 4 * fq; const float inv8 = inv * Y8_SCALE;
#pragma unroll
    for (int dt = 0; dt < 4; ++dt) { int w = 0; w = __builtin_amdgcn_cvt_pk_fp8_f32(o[dt][0] * inv8, o[dt][1] * inv8, w, false); w = __builtin_amdgcn_cvt_pk_fp8_f32(o[dt][2] * inv8, o[dt][3] * inv8, w, true); *(GAS unsigned*)(yo + dt * 16) = (unsigned)w; }
}

__device__ __forceinline__ void attn_unit(LAS unsigned char* lds, const bf16_t* Z, const float* sinks, bf16_t* YA, int unit, int tid) {
    const int b = unit >> 7, nbi = (unit >> 2) & 31, kvh = unit & 3;
    const int m_cur = b * SEQ + nbi * 128;
    LAS bf16_t* Ks = (LAS bf16_t*)lds; LAS bf16_t* Vt = (LAS bf16_t*)(lds + VS_OFF);
    const int wid = tid >> 6, lane = tid & 63, fr = lane & 15, fq = lane >> 4;
    const int h = kvh * 8 + wid;
    const bf16_t* qbase = Z + (size_t)(m_cur + fr) * INW + COL_Q + h * 64 + fq * 8;
    bf16x8 qn0 = *(const GAS bf16x8*)(qbase), qn1 = *(const GAS bf16x8*)(qbase + 32), qn2 = *(const GAS bf16x8*)(qbase + 16 * INW), qn3 = *(const GAS bf16x8*)(qbase + 16 * INW + 32);
    u32x4 kv[4], vv[4];
#pragma unroll
    for (int i = 0; i < 4; ++i) {
        const int c = tid + 512 * i, j = c >> 3, c8 = c & 7; const bool valid = (nbi > 0) || (j >= 128);
        const size_t ro = (size_t)(valid ? m_cur - 128 + j : m_cur) * INW;
        kv[i] = ld16(Z + ro + COL_K + kvh * 64 + c8 * 8); vv[i] = ld16(Z + ro + COL_V + kvh * 64 + c8 * 8);
    }
#pragma unroll
    for (int i = 0; i < 4; ++i) {
        const int c = tid + 512 * i, j = c >> 3, c8 = c & 7;
        *(LAS u32x4*)(Ks + j * KS_PITCH + c8 * 8) = kv[i];
        *(LAS u32x4*)(Vt + j * VS_PITCH + c8 * 8) = vv[i];
    }
    __syncthreads();
    const float sink = sinks[h];
    const float sink2 = sink * 1.4426950409f;
    const int dmask = ((4 * fq + 0 > fr) ? 1 : 0) | ((4 * fq + 1 > fr) ? 2 : 0) | ((4 * fq + 2 > fr) ? 4 : 0) | ((4 * fq + 3 > fr) ? 8 : 0);
    __builtin_amdgcn_s_waitcnt(0x0F70);
#pragma unroll 1
    for (int qp = 0; qp < 4; ++qp) {
        const bf16x8 qc0 = qn0, qc1 = qn1, qc2 = qn2, qc3 = qn3;
        const bf16_t* qnx = qbase + (size_t)(qp < 3 ? 32 * (qp + 1) : 96) * INW;
        qn0 = *(const GAS bf16x8*)(qnx); qn1 = *(const GAS bf16x8*)(qnx + 32); qn2 = *(const GAS bf16x8*)(qnx + 16 * INW); qn3 = *(const GAS bf16x8*)(qnx + 16 * INW + 32);
        attn_qg<false>(Ks, Vt, qc0, qc1, YA, m_cur, nbi, h, sink2, fr, fq, dmask, 2 * qp);
        attn_qg<true>(Ks, Vt, qc2, qc3, YA, m_cur, nbi, h, sink2, fr, fq, dmask, 2 * qp + 1);
    }
    __syncthreads();
}

__device__ __forceinline__ void conv_items(const bf16_t* Z, const float* cw, const float* cb, bf16_t* UC, int gw, int NGW, int lane) {
    for (int it = gw; it < 2048; it += NGW) {
        const int cblk = it & 3, tch = it >> 2, c8 = cblk * 512 + lane * 8, m0 = tch * 32;
        f32x4 w0[4], w1[4];
#pragma unroll
        for (int tap = 0; tap < 4; ++tap) { w0[tap] = ld4(cw + tap * DM + c8); w1[tap] = ld4(cw + tap * DM + c8 + 4); }
        const f32x4 b0 = ld4(cb + c8), b1 = ld4(cb + c8 + 4);
        const bf16_t* zp = Z + (size_t)m0 * INW + COL_U + c8;
        u32x4 h[3];
#pragma unroll
        for (int q = 0; q < 3; ++q) h[q] = ((m0 & (SEQ - 1)) == 0) ? (u32x4){0u, 0u, 0u, 0u} : ld16(zp - (size_t)(3 - q) * INW);
#pragma unroll 1
        for (int t0 = 0; t0 < 32; t0 += 8) {
            u32x4 r[8];
#pragma unroll
            for (int j = 0; j < 8; ++j) r[j] = ld16(zp + (size_t)(t0 + j) * INW);
#pragma unroll
            for (int j = 0; j < 8; ++j) {
                f32x4 a0 = b0, a1 = b1, u0, u1;
                unpack8(h[0], u0, u1); a0 += u0 * w0[0]; a1 += u1 * w1[0];
                unpack8(h[1], u0, u1); a0 += u0 * w0[1]; a1 += u1 * w1[1];
                unpack8(h[2], u0, u1); a0 += u0 * w0[2]; a1 += u1 * w1[2];
                unpack8(r[j], u0, u1); a0 += u0 * w0[3]; a1 += u1 * w1[3];
                st16(UC + (size_t)(m0 + t0 + j) * DM + c8, pack8(a0, a1));
                h[0] = h[1]; h[1] = h[2]; h[2] = r[j];
            }
        }
    }
}

constexpr int SC_PITCH = 72;
__device__ __forceinline__ void scan_unit(LAS unsigned char* lds, const bf16_t* LA2, const bf16_t* XIN, const bf16_t* GG, bf16_t* YL, int unit, int tid) {
    const int b = unit >> 6, cg = unit & 63, pair = tid & 15, sub = tid >> 4;
    const size_t base = (size_t)unit * SEQ * 32;
    LAS unsigned char* sA = lds; LAS unsigned char* sX = lds + 256 * SC_PITCH; LAS unsigned char* sG = lds + 2 * 256 * SC_PITCH;
    LAS float* sP = (LAS float*)(lds + 3 * 256 * SC_PITCH); LAS float* sH = sP + 1024; LAS float* sC = sH + 1024;
    if (tid < 32) sC[tid] = 0.f;
    u32x4 ra[2], rx[2], rg[2];
#pragma unroll
    for (int i = 0; i < 2; ++i) { const size_t o = base + (size_t)(tid + 512 * i) * 8; ra[i] = ld16(LA2 + o); rx[i] = ld16(XIN + o); rg[i] = ld16(GG + o); }
#pragma unroll 1
    for (int c = 0; c < 16; ++c) {
#pragma unroll
        for (int i = 0; i < 2; ++i) { const int q = tid + 512 * i, off = (q >> 2) * SC_PITCH + (q & 3) * 16;
            *(LAS u32x2*)(sA + off) = (u32x2){ra[i].x, ra[i].y}; *(LAS u32x2*)(sA + off + 8) = (u32x2){ra[i].z, ra[i].w};
            *(LAS u32x2*)(sX + off) = (u32x2){rx[i].x, rx[i].y}; *(LAS u32x2*)(sX + off + 8) = (u32x2){rx[i].z, rx[i].w};
            *(LAS u32x2*)(sG + off) = (u32x2){rg[i].x, rg[i].y}; *(LAS u32x2*)(sG + off + 8) = (u32x2){rg[i].z, rg[i].w}; }
        __syncthreads();
        if (c < 15) {
#pragma unroll
            for (int i = 0; i < 2; ++i) { const size_t o = base + (size_t)(c + 1) * 8192 + (size_t)(tid + 512 * i) * 8; ra[i] = ld16(LA2 + o); rx[i] = ld16(XIN + o); rg[i] = ld16(GG + o); }
        }
        float a0[8], a1[8], x0[8], x1[8]; float P0 = 1.f, P1 = 1.f, H0 = 0.f, H1 = 0.f;
        const int lo = (sub * 8) * SC_PITCH + pair * 4;
#pragma unroll
        for (int j = 0; j < 8; ++j) { const unsigned la = *(const LAS unsigned*)(sA + lo + j * SC_PITCH), xx = *(const LAS unsigned*)(sX + lo + j * SC_PITCH);
            a0[j] = __builtin_amdgcn_exp2f(bflo(la)); a1[j] = __builtin_amdgcn_exp2f(bfhi(la)); x0[j] = bflo(xx); x1[j] = bfhi(xx);
            H0 = a0[j] * H0 + x0[j]; P0 *= a0[j]; H1 = a1[j] * H1 + x1[j]; P1 *= a1[j]; }
        sP[sub * 32 + 2 * pair] = P0; sP[sub * 32 + 2 * pair + 1] = P1; sH[sub * 32 + 2 * pair] = H0; sH[sub * 32 + 2 * pair + 1] = H1;
        __syncthreads();
        float h0 = sC[2 * pair], h1 = sC[2 * pair + 1];
#pragma unroll 1
        for (int sI = 0; sI < sub; ++sI) { h0 = sP[sI * 32 + 2 * pair] * h0 + sH[sI * 32 + 2 * pair]; h1 = sP[sI * 32 + 2 * pair + 1] * h1 + sH[sI * 32 + 2 * pair + 1]; }
        unsigned char* yo = (unsigned char*)YL + (size_t)(b * SEQ + c * 256 + sub * 8) * DM + cg * 32 + 2 * pair;
#pragma unroll
        for (int j = 0; j < 8; ++j) { h0 = a0[j] * h0 + x0[j]; h1 = a1[j] * h1 + x1[j]; const unsigned g = *(const LAS unsigned*)(sG + lo + j * SC_PITCH);
            const float y0 = __builtin_amdgcn_fmed3f(h0 * bflo(g) * Y8_SCALE, -448.0f, 448.0f), y1 = __builtin_amdgcn_fmed3f(h1 * bfhi(g) * Y8_SCALE, -448.0f, 448.0f);
            *(GAS unsigned short*)(yo + (size_t)j * DM) = (unsigned short)__builtin_amdgcn_cvt_pk_fp8_f32(y0, y1, 0, false); }
        __syncthreads();
        if (sub == 31) { sC[2 * pair] = h0; sC[2 * pair + 1] = h1; }
    }
    __syncthreads();
}

__device__ __forceinline__ void router_unit(LAS unsigned char* lds, const float* H1, const bf16_t* WRH, const bf16_t* WRL, const float* b_r,
                                            float* topw, float* rstd2, int* elist, float* prs, float* pw, unsigned* ecnt, int unit, int tid) {
    const int wid = tid >> 6, lane = tid & 63, rg = wid >> 2, kq = wid & 3;
    LAS float* part = (LAS float*)lds;
    LAS float* ssp = part + 8 * 32 * 33;
    LAS float* lg = ssp + 256;
    LAS int* lcnt = (LAS int*)(lg + 64 * 33);
    LAS int* gbase = lcnt + 32;
    LAS float* lrs = (LAS float*)(gbase + 32);
    const int row0 = unit * 64;
    if (tid < 32) lcnt[tid] = 0;
    const float* xr = H1 + (size_t)(row0 + rg * 32 + (lane & 31)) * DM + kq * 512 + (lane >> 5) * 8;
    const bf16_t* wh = WRH + (size_t)(lane & 31) * DM + kq * 512 + (lane >> 5) * 8; const bf16_t* wl = WRL + (size_t)(lane & 31) * DM + kq * 512 + (lane >> 5) * 8;
    f32x16 acc;
#pragma unroll
    for (int i = 0; i < 16; ++i) acc[i] = 0.f;
    float ss = 0.f;
#pragma unroll 4
    for (int ks = 0; ks < 32; ++ks) {
        const f32x4 x0 = ld4(xr + ks * 16), x1 = ld4(xr + ks * 16 + 4);
        ss += (x0[0] * x0[0] + x0[1] * x0[1]) + (x0[2] * x0[2] + x0[3] * x0[3]) + (x1[0] * x1[0] + x1[1] * x1[1]) + (x1[2] * x1[2] + x1[3] * x1[3]);
        union { u32x4 u; bf16x8 v; } ah, alo, bh, bl;
        ah.u = pack8(x0, x1);
        f32x4 h0, h1; unpack8(ah.u, h0, h1);
        alo.u = pack8(x0 - h0, x1 - h1);
        bh.u = ld16(wh + ks * 16); bl.u = ld16(wl + ks * 16);
        acc = __builtin_amdgcn_mfma_f32_32x32x16_bf16(ah.v, bh.v, acc, 0, 0, 0);
        acc = __builtin_amdgcn_mfma_f32_32x32x16_bf16(alo.v, bh.v, acc, 0, 0, 0);
        acc = __builtin_amdgcn_mfma_f32_32x32x16_bf16(ah.v, bl.v, acc, 0, 0, 0);
    }
    ss += __shfl_xor(ss, 32);
    if (lane < 32) ssp[wid * 32 + lane] = ss;
#pragma unroll
    for (int r = 0; r < 16; ++r) { const int row = (r & 3) + 8 * (r >> 2) + 4 * (lane >> 5); part[(wid * 32 + row) * 33 + (lane & 31)] = acc[r]; }
    __syncthreads();
    {
        const int r = tid >> 3, e0 = (tid & 7) * 4, g = r >> 5, rr = r & 31;
        const float sq = (ssp[(g * 4 + 0) * 32 + rr] + ssp[(g * 4 + 1) * 32 + rr]) + (ssp[(g * 4 + 2) * 32 + rr] + ssp[(g * 4 + 3) * 32 + rr]);
        const float rs = 1.0f / sqrtf(sq * (1.0f / DM) + RMS_EPS);
#pragma unroll
        for (int j = 0; j < 4; ++j) { const int e = e0 + j;
            const float d = (part[((g * 4 + 0) * 32 + rr) * 33 + e] + part[((g * 4 + 1) * 32 + rr) * 33 + e]) + (part[((g * 4 + 2) * 32 + rr) * 33 + e] + part[((g * 4 + 3) * 32 + rr) * 33 + e]);
            lg[r * 33 + e] = d * rs + b_r[e]; }
        if ((tid & 7) == 0) { rstd2[row0 + r] = rs; lrs[r] = rs; }
    }
    __syncthreads();
    int pe[4], pp[4]; float pv[4];
    if (tid < 64) {
        int used = 0;
#pragma unroll
        for (int k = 0; k < 4; ++k) { float best = -3.0e38f; int bi = 0;
            for (int e = 0; e < 32; ++e) { const float v = lg[tid * 33 + e]; const bool free_ = ((used >> e) & 1) == 0; if (free_ && v > best) { best = v; bi = e; } }
            used |= 1 << bi; pe[k] = bi; pv[k] = best; }
        const float m0 = pv[0]; float sum = 0.f;
#pragma unroll
        for (int k = 0; k < 4; ++k) { pv[k] = __expf(pv[k] - m0); sum += pv[k]; }
        const float inv = 1.0f / sum;
#pragma unroll
        for (int k = 0; k < 4; ++k) { pv[k] *= inv; pp[k] = atomicAdd((int*)&lcnt[pe[k]], 1); }
    }
    __syncthreads();
    if (tid < 32) gbase[tid] = (int)__hip_atomic_fetch_add(ecnt + 64 * tid, (unsigned)lcnt[tid], __ATOMIC_RELAXED, __HIP_MEMORY_SCOPE_AGENT);
    __syncthreads();
    if (tid < 64) {
        const int row = row0 + tid;
#pragma unroll
        for (int k = 0; k < 4; ++k) { const size_t ix = (size_t)pe[k] * NTOK + gbase[pe[k]] + pp[k]; elist[ix] = row * 4 + k; prs[ix] = lrs[tid]; pw[ix] = pv[k]; topw[row * 4 + k] = pv[k]; }
    }
    __syncthreads();
}

constexpr int NPH = 13;
#ifndef N_CONV_WG
#define N_CONV_WG 64
#endif
#define FRESH_TID() ({ int _t = threadIdx.x; asm volatile("" : "+v"(_t)); _t; })
#define WSP(T, off) ((T*)(ws + (off)))
__global__ void __launch_bounds__(NTHR, 2) mega(Args a) {
    extern __shared__ __attribute__((aligned(16))) unsigned char lds_raw[];
    LAS unsigned char* lds = (LAS unsigned char*)lds_raw;
    volatile LAS unsigned* MISC = (volatile LAS unsigned*)(lds + MISC_OFF);
    const int G = gridDim.x, bx = blockIdx.x, NGW = G * NWAVES;
    unsigned char* ws = a.ws; unsigned* ctl = (unsigned*)(ws + WS_CTL);
    const int lo = a.ph_lo, hi = a.ph_hi;
    if (threadIdx.x < 4) MISC[threadIdx.x] = 0u;
    __syncthreads();
    XcdBarrier bar; bar.bar = ctl + CW_BAR; bar.x = 0; bar.st = MISC;
    if (hi - lo > 1) bar = xcd_barrier_post(ctl + CW_BAR, MISC);
#ifndef PH_MASK
#define PH_MASK 0xFFFF
#endif
#ifndef REPEAT_MASK
#define REPEAT_MASK 0
#endif
#ifndef MOE2_REP_STUB
#define MOE2_REP_STUB 0
#endif
#define IN(k) (((PH_MASK >> (k)) & 1) && lo <= (k) && (k) < hi)
#define SEAM(k) do { if (IN(k) && IN((k) + 1)) xcd_barrier(bar); } while (0)
#define WAVE_IDS() const int tid = FRESH_TID(); const int lane = tid & 63, wave = __builtin_amdgcn_readfirstlane(tid >> 6), gw = bx * NWAVES + wave; (void)lane; (void)gw

    if (IN(0)) { WAVE_IDS(); p0_prologue(a, lds, gw, NGW, lane, wave); }
#if (REPEAT_MASK >> 0) & 1
    if (IN(0)) { WAVE_IDS(); p0_prologue(a, lds, gw, NGW, lane, wave); }
#endif
    SEAM(0);
    if (IN(1)) {
        WAVE_IDS(); volatile LAS int* mbox = (volatile LAS int*)(lds + MISC_OFF + 512);
        ProbInProj p; p.S.init(64, 42, G, bx); p.A = WSP(bf16_t, WS_XB); p.Bt = WSP(bf16_t, WS_WIN); p.rstd = WSP(float, WS_RSTD1); p.bias = a.in[4]; p.Z = WSP(bf16_t, WS_Z); p.GG = WSP(bf16_t, WS_GG);
        p.D.q = ctl + CW_QG1; p.D.slot = mbox; p.D.x0 = (int)(xb_xcc_id() & 7u); p.D.nper = 8 * PN_GA; p.D.pn0 = 0;
        ProbInProj8 p8; p8.XQ = WSP(unsigned char, WS_H1Q); p8.W8 = WSP(unsigned char, WS_WIN8); p8.rstd = WSP(float, WS_RSTD1); p8.bias = a.in[4]; p8.Z = WSP(bf16_t, WS_Z); p8.GG = WSP(bf16_t, WS_GG);
        p8.D.q = ctl + CW_QG1 + 32; p8.D.slot = mbox; p8.D.x0 = p.D.x0; p8.D.nper = 8 * (42 - PN_GA); p8.D.pn0 = PN_GA;
        const int per_wg = (NB_ALL + G - 1) / G;
#ifndef CONV_GROUPS
#define CONV_GROUPS 2
#endif
#define CONV_SLOT(sl) do { if ((bx % CONV_GROUPS) == (sl)) { \
            const int w0 = bx * per_wg; int n = per_wg; if (w0 + n > NB_ALL) n = NB_ALL - w0; \
            moe_convert_blocks(a.in[19], a.in[21], a.in[16], ws, w0, n, lds, wave, lane, a.in[25], a.in[23], a.in[3], a.in[2], a.in[13], a.in[14], a.in[15]); } } while (0)
#if PN8_FIRST > 0
        CONV_SLOT(0); p.D.quota = 4; gemm_phase(lds, p);
        CONV_SLOT(1); p.D.quota = 1 << 20; gemm_phase(lds, p);
        p8.D.quota = 1 << 20; gemm_phase(lds, p8);
#else
        (void)p;
        CONV_SLOT(0); p8.D.quota = P1_Q1; gemm_phase(lds, p8);
        CONV_SLOT(1); p8.D.quota = 1 << 20; gemm_phase(lds, p8);
#endif
#undef CONV_SLOT
    }
    SEAM(1);
    if (IN(2)) {
        WAVE_IDS();
#ifndef NO_ATTN
        for (int u = bx; u < 512; u += G) attn_unit(lds, WSP(bf16_t, WS_Z), a.in[12], WSP(bf16_t, WS_YA), u, tid);
#endif
#ifndef NO_CONV
        conv_items(WSP(bf16_t, WS_Z), a.in[5], a.in[6], WSP(bf16_t, WS_UC), gw, NGW, lane);
#endif
    }
#if (REPEAT_MASK >> 2) & 1
    if (IN(2)) {
        WAVE_IDS();
#ifndef REP_NO_ATTN
        for (int u = bx; u < 512; u += G) attn_unit(lds, WSP(bf16_t, WS_Z), a.in[12], WSP(bf16_t, WS_YA), u, tid);
#endif
#ifndef REP_NO_CONV
        conv_items(WSP(bf16_t, WS_Z), a.in[5], a.in[6], WSP(bf16_t, WS_UC), gw, NGW, lane);
#endif
    }
#endif
    SEAM(2);
    if (IN(3)) { ProbGates p; p.G = G; p.c = bx; p.UC = WSP(bf16_t, WS_UC); p.W = WSP(bf16_t, WS_WRG); p.b_a = a.in[8]; p.b_x = a.in[10]; p.lam = a.in[11]; p.LA2 = WSP(bf16_t, WS_LA2); p.XIN = WSP(bf16_t, WS_XIN); gemm_phase(lds, p); }
#if (REPEAT_MASK >> 3) & 1
    if (IN(3)) { ProbGates p; p.G = G; p.c = bx; p.UC = WSP(bf16_t, WS_UC); p.W = WSP(bf16_t, WS_WRG); p.b_a = a.in[8]; p.b_x = a.in[10]; p.lam = a.in[11]; p.LA2 = WSP(bf16_t, WS_LA2); p.XIN = WSP(bf16_t, WS_XIN); gemm_phase(lds, p); }
#endif
    SEAM(3);
    if (IN(4)) { WAVE_IDS(); for (int u = bx; u < 256; u += G) scan_unit(lds, WSP(bf16_t, WS_LA2), WSP(bf16_t, WS_XIN), WSP(bf16_t, WS_GG), WSP(bf16_t, WS_YL), u, tid); }
#if (REPEAT_MASK >> 4) & 1
    if (IN(4)) { WAVE_IDS(); for (int u = bx; u < 256; u += G) scan_unit(lds, WSP(bf16_t, WS_LA2), WSP(bf16_t, WS_XIN), WSP(bf16_t, WS_GG), WSP(bf16_t, WS_YL), u, tid); }
#endif
    SEAM(4);
    if (IN(5)) { ProbProj2 p; p.S.init(64, 8, G, bx); p.YA = WSP(bf16_t, WS_YA); p.YL = WSP(bf16_t, WS_YL); p.WA = WSP(bf16_t, WS_WAP); p.WL = WSP(bf16_t, WS_WLP); p.Z = WSP(bf16_t, WS_Z); p.MG = WSP(bf16_t, WS_MG); gemm_phase(lds, p); }
#if (REPEAT_MASK >> 5) & 1
    if (IN(5)) { ProbProj2 p; p.S.init(64, 8, G, bx); p.YA = WSP(bf16_t, WS_YA); p.YL = WSP(bf16_t, WS_YL); p.WA = WSP(bf16_t, WS_WAP); p.WL = WSP(bf16_t, WS_WLP); p.Z = WSP(bf16_t, WS_Z); p.MG = WSP(bf16_t, WS_MG); gemm_phase(lds, p); }
#endif
    SEAM(5);
    if (IN(6)) { ProbOut p; p.S.init(64, 8, G, bx); p.A = WSP(bf16_t, WS_MG); p.Bt = WSP(bf16_t, WS_WOUT); p.X = a.in[0]; p.H1 = WSP(float, WS_H1); p.H1Q = WSP(unsigned char, WS_H1Q); gemm_phase(lds, p); }
#if (REPEAT_MASK >> 6) & 1
    if (IN(6)) { ProbOut p; p.S.init(64, 8, G, bx); p.A = WSP(bf16_t, WS_MG); p.Bt = WSP(bf16_t, WS_WOUT); p.X = a.in[0]; p.H1 = WSP(float, WS_H1); p.H1Q = WSP(unsigned char, WS_H1Q); gemm_phase(lds, p); }
#endif
    SEAM(6);
    if (IN(7)) { WAVE_IDS(); for (int u = bx; u < 256; u += G) router_unit(lds, WSP(float, WS_H1), WSP(bf16_t, WS_WR), WSP(bf16_t, WS_WR) + NEXP * DM, a.in[18], WSP(float, WS_TOPW), WSP(float, WS_RSTD2), WSP(int, WS_ELIST), WSP(float, WS_PRS), WSP(float, WS_PW), ctl + CW_ECNT, u, tid); }
#if (REPEAT_MASK >> 7) & 1
    if (IN(7)) { WAVE_IDS(); for (int u = bx; u < 256; u += G) router_unit(lds, WSP(float, WS_H1), WSP(bf16_t, WS_WR), WSP(bf16_t, WS_WR) + NEXP * DM, a.in[18], WSP(float, WS_TOPW), WSP(float, WS_RSTD2), WSP(int, WS_ELIST), WSP(float, WS_PRS), WSP(float, WS_PW), ctl + CW_ECNT, u, tid); }
#endif
    SEAM(7);
    volatile LAS int* tab = (volatile LAS int*)(lds + MISC_OFF + 64);
    if (IN(8) || IN(9)) {
        if (threadIdx.x == 0) { int tp = 0, bp = 0;
            for (int e = 0; e < 32; ++e) { int cn = (int)__hip_atomic_load(ctl + CW_ECNT + 64 * e, __ATOMIC_RELAXED, __HIP_MEMORY_SCOPE_AGENT); cn = cn < 0 ? 0 : (cn > NTOK ? NTOK : cn); tab[e] = tp; tab[33 + e] = bp; tp += (cn + 255) >> 8; bp += cn; }
            tab[32] = tp; tab[65] = bp; }
        __syncthreads();
        if (threadIdx.x < 288) { const int g = threadIdx.x; int e = 0; for (int j = 0; j < 32; ++j) e += (g >= tab[j + 1]) ? 1 : 0; ((volatile LAS unsigned char*)(lds + MISC_OFF + 640))[g] = (unsigned char)(e > 31 ? 31 : e); }
        __syncthreads();
    }
    if (IN(8)) { ProbMoe1 p; p.G = G; p.c = bx; p.tab = tab; p.H1Q = WSP(unsigned char, WS_H1Q); p.W1 = WSP(unsigned char, WS_W1); p.elist = WSP(int, WS_ELIST); p.rstd2 = WSP(float, WS_RSTD2); p.prs = WSP(float, WS_PRS); p.b1 = a.in[20]; p.ACT = WSP(unsigned char, WS_ACT); gemm_phase(lds, p); }
#if (REPEAT_MASK >> 8) & 1
    if (IN(8)) { ProbMoe1 p; p.G = G; p.c = bx; p.tab = tab; p.H1Q = WSP(unsigned char, WS_H1Q); p.W1 = WSP(unsigned char, WS_W1); p.elist = WSP(int, WS_ELIST); p.rstd2 = WSP(float, WS_RSTD2); p.prs = WSP(float, WS_PRS); p.b1 = a.in[20]; p.ACT = WSP(unsigned char, WS_ACT); gemm_phase(lds, p); }
#endif
    SEAM(8);
    if (IN(9)) { ProbMoe2 p; p.G = G; p.c = bx; p.tab = tab; p.ACT = WSP(unsigned char, WS_ACT); p.W2 = WSP(unsigned char, WS_W2); p.elist = WSP(int, WS_ELIST); p.topw = WSP(float, WS_TOPW); p.pw = WSP(float, WS_PW); p.b2 = a.in[22]; p.YB = WSP(unsigned char, WS_YB); gemm_phase(lds, p); }
#if (REPEAT_MASK >> 9) & 1
    if (IN(9)) { ProbMoe2T<MOE2_REP_STUB> p; p.G = G; p.c = bx; p.tab = tab; p.ACT = WSP(unsigned char, WS_ACT); p.W2 = WSP(unsigned char, WS_W2); p.elist = WSP(int, WS_ELIST); p.topw = WSP(float, WS_TOPW); p.pw = WSP(float, WS_PW); p.b2 = a.in[22]; p.YB = WSP(unsigned char, WS_YB); gemm_phase(lds, p); }
#endif
    SEAM(9);
    if (IN(10)) {
        WAVE_IDS(); float* H1 = WSP(float, WS_H1); bf16_t* H1B = WSP(bf16_t, WS_H1B); const unsigned char* YB = WSP(unsigned char, WS_YB); float* RSTD3 = WSP(float, WS_RSTD3); unsigned char* H2Q = WSP(unsigned char, WS_H1Q);
        for (int m = gw; m < NTOK; m += NGW) {
            float ss = 0.f;
#pragma unroll
            for (int j = 0; j < 4; ++j) {
                const size_t o = (size_t)m * DM + j * 512 + lane * 8; f32x4 v0 = ld4(H1 + o), v1 = ld4(H1 + o + 4);
                f32x4 s0 = {0.f, 0.f, 0.f, 0.f}, s1 = s0;
#pragma unroll
                for (int k = 0; k < 4; ++k) { f32x4 y0, y1; unpack8_fp8(*(const GAS u32x2*)(YB + ((size_t)m * 4 + k) * DM + j * 512 + lane * 8), y0, y1); s0 += y0; s1 += y1; }
                v0 += s0 * (1.0f / YB8_SCALE); v1 += s1 * (1.0f / YB8_SCALE);
                ss += (v0[0] * v0[0] + v0[1] * v0[1]) + (v0[2] * v0[2] + v0[3] * v0[3]) + (v1[0] * v1[0] + v1[1] * v1[1]) + (v1[2] * v1[2] + v1[3] * v1[3]);
                st16(H1B + o, pack8(v0, v1));
                st8(H2Q + o, pack8_fp8(v0, v1));
            }
            ss = wave_sum(ss);
            if (lane == 0) RSTD3[m] = 1.0f / sqrtf(ss * (1.0f / DM) + RMS_EPS);
        }
    }
    SEAM(10);
    if (IN(11)) {
        { ProbPle p; p.S.init(64, 8, G, bx); p.A = WSP(bf16_t, WS_PB); p.Bt = WSP(bf16_t, WS_WPLE); p.PE = WSP(bf16_t, WS_PE); gemm_phase(lds, p); }
        { ProbGate8 p; p.S.init(64, 8, G, bx); p.H2Q = WSP(unsigned char, WS_H1Q); p.WPG8 = WSP(unsigned char, WS_WPG); p.H2B = WSP(bf16_t, WS_H1B); p.PE = WSP(bf16_t, WS_PE);
          p.rstd3 = WSP(float, WS_RSTD3); p.H3B = WSP(bf16_t, WS_M1); p.SS3 = WSP(float, WS_SS3); gemm_phase(lds, p); }
    }
    SEAM(11);
    if (IN(12)) {
        WAVE_IDS(); const float* gf = a.in[26]; const float* SS3 = WSP(float, WS_SS3); const bf16_t* H3B = WSP(bf16_t, WS_M1);
        for (int m = gw; m < NTOK; m += NGW) {
            float ss = (lane < 32) ? SS3[(size_t)m * 32 + lane] : 0.f; ss = wave_sum(ss);
            const float rs = 1.0f / sqrtf(ss * (1.0f / DM) + RMS_EPS);
#pragma unroll
            for (int j = 0; j < 4; ++j) { const size_t o = (size_t)m * DM + j * 512 + lane * 8; const int c = j * 512 + lane * 8;
                f32x4 h0, h1; unpack8(ld16(H3B + o), h0, h1);
                st4(a.out + o, h0 * rs * ld4(gf + c)); st4(a.out + o + 4, h1 * rs * ld4(gf + c + 4)); }
        }
    }
#ifdef DBG_STOP
    if (lo == 13) {
        WAVE_IDS(); const float* H1 = WSP(float, WS_H1); (void)H1;
#ifdef DBG_BUF
        const bf16_t* src = (const bf16_t*)(ws + DBG_BUF);
        for (int m = gw; m < NTOK; m += NGW) {
#pragma unroll
            for (int j = 0; j < 4; ++j) { const size_t o = (size_t)m * DM + j * 512 + lane * 8; f32x4 b0, b1; unpack8(ld16(src + (size_t)m * DBG_LD + DBG_COFF + j * 512 + lane * 8), b0, b1);
                for (int q = 0; q < 4; ++q) { if (!(fabsf(b0[q]) < 1e30f)) b0[q] = 1000.f; if (!(fabsf(b1[q]) < 1e30f)) b1[q] = 1000.f; }
                st4(a.out + o, ld4(a.in[0] + o) + b0); st4(a.out + o + 4, ld4(a.in[0] + o + 4) + b1); }
        }
#else
        const float* gf = a.in[26];
        for (int m = gw; m < NTOK; m += NGW) {
            float ss = 0.f; f32x4 v[8];
#pragma unroll
            for (int j = 0; j < 4; ++j) { const size_t o = (size_t)m * DM + j * 512 + lane * 8; v[2 * j] = ld4(H1 + o); v[2 * j + 1] = ld4(H1 + o + 4);
                for (int q = 0; q < 4; ++q) ss += v[2 * j][q] * v[2 * j][q] + v[2 * j + 1][q] * v[2 * j + 1][q]; }
            ss = wave_sum(ss);
            const float rs = 1.0f / sqrtf(ss * (1.0f / DM) + RMS_EPS);
#pragma unroll
            for (int j = 0; j < 4; ++j) { const size_t o = (size_t)m * DM + j * 512 + lane * 8; const int c = j * 512 + lane * 8;
                st4(a.out + o, v[2 * j] * rs * ld4(gf + c)); st4(a.out + o + 4, v[2 * j + 1] * rs * ld4(gf + c + 4)); }
        }
#endif
    }
#endif
#undef IN
#undef SEAM
}

extern "C" void kernel_launch(void* const* d_in, const int* in_sizes, int n_in, void* d_out, int out_size, void* d_ws, size_t ws_size, hipStream_t stream) {
    static int grid = 0;
    if (grid == 0) {
        if (n_in != 27 || out_size != NTOK * DM || ws_size < WS_END) { fprintf(stderr, "kernel_launch: unexpected shapes (n_in %d out %d ws %zu need %zu)\n", n_in, out_size, ws_size, (size_t)WS_END); grid = -1; return; }
        int dev = 0, cus = 0, per_cu = 0;
        if (hipGetDevice(&dev) != hipSuccess || hipDeviceGetAttribute(&cus, hipDeviceAttributeMultiprocessorCount, dev) != hipSuccess) { grid = -1; return; }
        if (hipFuncSetAttribute((const void*)mega, hipFuncAttributeMaxDynamicSharedMemorySize, LDS_BYTES) != hipSuccess) { fprintf(stderr, "kernel_launch: hipFuncSetAttribute failed\n"); grid = -1; return; }
        if (hipOccupancyMaxActiveBlocksPerMultiprocessor(&per_cu, (const void*)mega, NTHR, LDS_BYTES) != hipSuccess || per_cu < 1) fprintf(stderr, "kernel_launch: occupancy query says %d\n", per_cu);
        (void)hipGetLastError();
        grid = cus;
    }
    if (grid < 0) return;
    (void)hipMemsetAsync((char*)d_ws + WS_CTL, 0, CTL_BYTES, stream);
    Args a{};
    for (int i = 0; i < 27; ++i) a.in[i] = (const float*)d_in[i];
    a.out = (float*)d_out; a.ws = (unsigned char*)d_ws;
#if MK_SINGLE
    a.ph_lo = 0; a.ph_hi = NPH;
    hipLaunchKernelGGL(mega, dim3(grid), dim3(NTHR), LDS_BYTES, stream, a);
#else
#ifdef DBG_STOP
    for (int ph = 0; ph <= DBG_STOP; ++ph) { a.ph_lo = ph; a.ph_hi = ph + 1; hipLaunchKernelGGL(mega, dim3(grid), dim3(NTHR), LDS_BYTES, stream, a); }
    a.ph_lo = 13; a.ph_hi = 14; hipLaunchKernelGGL(mega, dim3(grid), dim3(NTHR), LDS_BYTES, stream, a);
#else
    for (int ph = 0; ph < NPH; ++ph) { a.ph_lo = ph; a.ph_hi = ph + 1; hipLaunchKernelGGL(mega, dim3(grid), dim3(NTHR), LDS_BYTES, stream, a); }
#endif
#endif
}
```

```cpp
#include <hip/hip_runtime.h>
#include <stdint.h>
#include <stdio.h>

#ifndef PN8_FIRST
#define PN8_FIRST 0
#endif
#ifndef P1_Q1
#define P1_Q1 7
#endif
#ifndef MK_SINGLE
#define MK_SINGLE 1
#endif

#ifndef ATT_DBG
#define ATT_DBG 0
#endif
#define LAS __attribute__((address_space(3)))
#define GAS __attribute__((address_space(1)))
typedef unsigned short bf16_t;
typedef short bf16x8 __attribute__((ext_vector_type(8)));
typedef float f32x4 __attribute__((ext_vector_type(4)));
typedef float f32x16 __attribute__((ext_vector_type(16)));
typedef unsigned u32x4 __attribute__((ext_vector_type(4)));
typedef unsigned u32x2 __attribute__((ext_vector_type(2)));
typedef int i32x8 __attribute__((ext_vector_type(8)));
typedef int i32x4 __attribute__((ext_vector_type(4)));

constexpr int NTOK = 16384, SEQ = 4096, DM = 2048, INW = 10752;
constexpr int COL_Q = 0, COL_K = 2048, COL_V = 2304, COL_U = 2560, COL_GATE = 4608, COL_GA = 6656, COL_GL = 8704;
constexpr int NEXP = 32, TOPK = 4, DFF = 2048, PLE = 256;
constexpr float RMS_EPS = 1e-6f;
constexpr float QK_SCALE = 0.125f * 1.4426950409f;

constexpr size_t MiB = 1u << 20;
constexpr size_t al(size_t x) { return (x + 4095) & ~(size_t)4095; }
constexpr size_t WS_CTL = 0, CTL_BYTES = 1 * MiB;
constexpr size_t WS_WIN = CTL_BYTES;
constexpr size_t WS_WIN8 = WS_WIN + (size_t)(PN8_FIRST * 256) * DM * 2;
constexpr size_t WS_WAP = WS_WIN + al((size_t)INW * DM * 2);
constexpr size_t WS_WLP = WS_WAP + al((size_t)DM * DM * 2);
constexpr size_t WS_WOUT = WS_WLP + al((size_t)DM * DM * 2);
constexpr size_t WS_WPG = WS_WOUT + al((size_t)DM * DM * 2);
constexpr size_t WS_WPLE = WS_WPG + al((size_t)DM * DM * 2);
constexpr size_t WS_WRG = WS_WPLE + al((size_t)DM * PLE * 2);
constexpr size_t WS_WR = WS_WRG + al((size_t)2 * 8 * 256 * 256 * 2);
constexpr size_t WS_W1 = WS_WR + al((size_t)2 * NEXP * DM * 2);
constexpr size_t WS_W2 = WS_W1 + al((size_t)NEXP * 2 * DFF * DM * 2);
constexpr size_t WS_XB = WS_W2 + al((size_t)NEXP * DM * DFF * 2);
constexpr size_t WS_RSTD1 = WS_XB + al((size_t)NTOK * DM * 2);
constexpr size_t WS_Z = WS_RSTD1 + al((size_t)NTOK * 4);
constexpr size_t WS_YA = WS_Z + al((size_t)NTOK * INW * 2);
constexpr size_t WS_UC = WS_YA + al((size_t)NTOK * DM * 2);
constexpr size_t WS_LA2 = WS_UC + al((size_t)NTOK * DM * 2);
constexpr size_t WS_GG = WS_LA2 + al((size_t)NTOK * DM * 2);
constexpr size_t WS_XIN = WS_GG + al((size_t)NTOK * DM * 2);
constexpr size_t WS_YL = WS_XIN + al((size_t)NTOK * DM * 2);
constexpr size_t WS_M1 = WS_YL + al((size_t)NTOK * DM * 2);
constexpr size_t WS_MG = WS_M1 + al((size_t)NTOK * DM * 4);
constexpr size_t WS_H1 = WS_MG + al((size_t)NTOK * DM * 2);
constexpr size_t WS_H1B = WS_H1 + al((size_t)NTOK * DM * 4);
constexpr size_t WS_TOPW = WS_H1B + al((size_t)NTOK * DM * 2);
constexpr size_t WS_RSTD2 = WS_TOPW + al((size_t)NTOK * 4 * 4);
constexpr size_t WS_RSTD3 = WS_RSTD2 + al((size_t)NTOK * 4);
constexpr size_t WS_ELIST = WS_RSTD3 + al((size_t)NTOK * 4);
constexpr size_t WS_ACT = WS_ELIST + al((size_t)NEXP * NTOK * 4);
constexpr size_t WS_YB = WS_ACT + al((size_t)(NTOK * 4 + 512) * DFF * 2);
constexpr size_t WS_PB = WS_YB + al((size_t)NTOK * 4 * DM * 2);
constexpr size_t WS_PE = WS_PB + al((size_t)NTOK * PLE * 2);
constexpr size_t WS_SS3 = WS_PE + al((size_t)NTOK * DM * 4);
constexpr size_t WS_H1Q = WS_SS3 + al((size_t)NTOK * 32 * 4);
constexpr size_t WS_PRS = WS_H1Q + al((size_t)NTOK * DM);
constexpr size_t WS_PW = WS_PRS + al((size_t)NEXP * NTOK * 4);
constexpr size_t WS_END = WS_PW + al((size_t)NEXP * NTOK * 4);
constexpr int CW_BAR = 1024;
constexpr int CW_ECNT = 8192;
constexpr int CW_QCONV = 12288;
constexpr int CW_QG1 = 12352;

constexpr int NWAVES = 8, NTHR = 512;
constexpr int LDS_BYTES = 147456, MISC_OFF = 146432;

typedef float f32x2 __attribute__((ext_vector_type(2)));
typedef __bf16 bf16v2 __attribute__((ext_vector_type(2)));
__device__ __forceinline__ unsigned pk2(float lo, float hi) { f32x2 f = {lo, hi}; bf16v2 b = __builtin_convertvector(f, bf16v2); return __builtin_bit_cast(unsigned, b); }
__device__ __forceinline__ float bflo(unsigned u) { return __uint_as_float(u << 16); }
__device__ __forceinline__ float bfhi(unsigned u) { return __uint_as_float(u & 0xffff0000u); }
__device__ __forceinline__ float fsigmoid(float x) { return __builtin_amdgcn_rcpf(1.0f + __builtin_amdgcn_exp2f(-1.4426950409f * x)); }
__device__ __forceinline__ float gelu_tanh(float x) { const float t = 0.7978845608f * (x + 0.044715f * x * x * x); return x * fsigmoid(2.0f * t); }
__device__ __forceinline__ float wave_sum(float v) {
#pragma unroll
    for (int o = 1; o < 64; o <<= 1) v += __shfl_xor(v, o);
    return v;
}
#define LDS_WAIT() asm volatile("s_waitcnt lgkmcnt(0)" ::: "memory")
#define VM_WAIT() asm volatile("s_waitcnt vmcnt(0)" ::: "memory")

#define XB_TMO      128
#define XB_XCNT(j)  (256  + 64 * (j))
#define XB_XSUB(j)  (1280 + 64 * (j))
#define XB_XGEN(j)  (2304 + 64 * (j))
#define XB_TOP      3328
#define XB_TOPGEN   3392
#define XCD_BAR_WORDS 3456
#define XB_SPIN_CAP (1u << 18)
__device__ __forceinline__ unsigned xb_ld(unsigned* p)              { return __hip_atomic_load(p, __ATOMIC_RELAXED, __HIP_MEMORY_SCOPE_AGENT); }
__device__ __forceinline__ unsigned xb_add(unsigned* p, unsigned v) { return __hip_atomic_fetch_add(p, v, __ATOMIC_RELAXED, __HIP_MEMORY_SCOPE_AGENT); }
__device__ __forceinline__ unsigned xb_xcc_id() { return (unsigned)__builtin_amdgcn_s_getreg((3 << 11) | 20) & 0xFu; }
#define XB_SPIN(cond, bar) do { unsigned _sp = 0; while (cond) { __builtin_amdgcn_s_sleep(1); \
    if ((++_sp & 255u) == 0u) { if (xb_ld(&(bar)[XB_TMO])) break; if (_sp > XB_SPIN_CAP) { atomicAdd(&(bar)[XB_TMO], 1u); break; } } } } while (0)
struct XcdBarrier { unsigned* bar; unsigned x; volatile LAS unsigned* st; };
__device__ __forceinline__ XcdBarrier xcd_barrier_post(unsigned* bar, volatile LAS unsigned* st) {
    XcdBarrier b; b.bar = bar; b.x = xb_xcc_id(); b.st = st;
    if (threadIdx.x == 0) (void)xb_add(&bar[XB_XCNT(b.x)], 1u);
    return b;
}
__device__ __forceinline__ void xcd_barrier_complete(unsigned* bar, unsigned x, unsigned& nloc, unsigned& nx) {
    const unsigned G = gridDim.x * gridDim.y * gridDim.z;
    unsigned sum, cnt, mine, sp = 0u;
    for (;;) {
        sum = 0u; cnt = 0u; mine = 0u;
#pragma unroll
        for (unsigned j = 0; j < 16; ++j) { const unsigned c = xb_ld(&bar[XB_XCNT(j)]); sum += c; cnt += (c > 0u) ? 1u : 0u; mine = (j == x) ? c : mine; }
        if (sum == G) break;
        __builtin_amdgcn_s_sleep(1);
        if ((++sp & 255u) == 0u) { if (xb_ld(&bar[XB_TMO])) break; if (sp > XB_SPIN_CAP) { atomicAdd(&bar[XB_TMO], 1u); break; } }
    }
    nloc = mine > 0u ? mine : 1u; nx = cnt > 0u ? cnt : 1u;
}
__device__ __forceinline__ void xcd_barrier(const XcdBarrier& b) {
    asm volatile("s_waitcnt vmcnt(0)" ::: "memory");
    __syncthreads();
    if (threadIdx.x == 0) {
        unsigned* bar = b.bar;
        __builtin_amdgcn_s_waitcnt(0);
        unsigned nloc = b.st[0], nx = b.st[1];
        if (nloc == 0u) { xcd_barrier_complete(bar, b.x, nloc, nx); b.st[0] = nloc; b.st[1] = nx; }
        const unsigned old = xb_add(&bar[XB_XSUB(b.x)], 1u);
        const unsigned gen = old / nloc;
        if (old + 1u == (gen + 1u) * nloc) {
            __builtin_amdgcn_fence(__ATOMIC_RELEASE, "agent");
            asm volatile("s_waitcnt vmcnt(0)" ::: "memory");
            const unsigned og = xb_add(&bar[XB_TOP], 1u);
            const unsigned tg = og / nx;
            if (og + 1u == (tg + 1u) * nx) xb_add(&bar[XB_TOPGEN], 1u);
            else XB_SPIN(xb_ld(&bar[XB_TOPGEN]) == tg, bar);
            __builtin_amdgcn_fence(__ATOMIC_ACQUIRE, "agent");
            xb_add(&bar[XB_XGEN(b.x)], 1u);
            asm volatile("s_waitcnt vmcnt(0)" ::: "memory");
        } else {
            XB_SPIN(xb_ld(&bar[XB_XGEN(b.x)]) == gen, bar);
            __builtin_amdgcn_fence(__ATOMIC_ACQUIRE, "agent");
            asm volatile("s_waitcnt vmcnt(0)" ::: "memory");
        }
    }
    __syncthreads();
}

namespace g8 {
constexpr int BM = 256, BK = 64, HALF = 128, HTB = HALF * BK * 2, STAGE_BYTES = 8 * HTB, NXCD = 8, WGM = 8;
__device__ __forceinline__ int lds_byte(int r, int c) { const int st = (r >> 4) * 2 + (c >> 5), rr = r & 15, cc = c & 31, ob = rr * 64 + cc * 2; return st * 1024 + (ob ^ (((ob >> 9) & 1) << 5)); }
__device__ __forceinline__ void stage_rc(int b, int& R, int& C) { const int st = b / 1024, sb = b % 1024, swz = sb ^ (((sb >> 9) & 1) << 5); R = (st >> 1) * 16 + swz / 64; C = (st & 1) * 32 + (swz % 64) / 2; }
__device__ __forceinline__ int perm32(int rho) { const int n = rho >> 4, i = rho & 15; return 8 * (i >> 2) + 4 * n + (i & 3); }

typedef __amdgpu_buffer_rsrc_t Rsrc;
__device__ __forceinline__ Rsrc mk_rsrc(const void* p) {
    const unsigned long long a = (unsigned long long)p; const unsigned lo = __builtin_amdgcn_readfirstlane((unsigned)a), hi = __builtin_amdgcn_readfirstlane((unsigned)(a >> 32));
    return __builtin_amdgcn_make_buffer_rsrc((void*)(((unsigned long long)hi << 32) | lo), 0, 0x7fffffff, 0x00020000); }
__device__ __forceinline__ unsigned voff_b(int tid, int ldbb) { int tz = tid; asm volatile("" : "+v"(tz)); int R, C; stage_rc(tz * 16, R, C); const int Rb = (R & ~31) + perm32(R & 31); return (unsigned)(Rb * ldbb + C * 2); }
struct Unit2 { int pm, pn; };
struct StaticOrder {
    int nM, nN, nwg, G, c;
    __device__ void init(int nM_, int nN_, int G_, int c_) { nM = nM_; nN = nN_; nwg = nM * nN; G = G_; c = c_; }
    __device__ bool next(int i, Unit2& u) const {
        const long L = (long)i * G + c; if (L >= nwg) return false;
        int wgid = (int)L; { const int q = nwg / NXCD, r = nwg % NXCD, xcd = wgid % NXCD, off = wgid / NXCD; wgid = (xcd < r ? xcd * (q + 1) : r * (q + 1) + (xcd - r) * q) + off; }
        const int nig = WGM * nN, gid = wgid / nig, fm = gid * WGM, gsz = (nM - fm) < WGM ? (nM - fm) : WGM;
        u.pm = fm + ((wgid % nig) % gsz); u.pn = (wgid % nig) / gsz; return true;
    }
};

template <class P>
__device__ __forceinline__ void gemm_phase(LAS unsigned char* lds, const P& p) {
    int tid = threadIdx.x; asm volatile("" : "+v"(tid));
    const int wid = __builtin_amdgcn_readfirstlane(tid >> 6), lane = tid & 63, wr = wid >> 2, wc = wid & 3, fr = lane & 15, fq = lane >> 4;
    const unsigned ldsw = (unsigned)wid * 1024u;
    int aoff = lds_byte(wr * 64 + fr, fq * 8), boff = lds_byte(wc * 32 + fr, fq * 8) + 4 * HTB;
    asm volatile("" : "+v"(aoff), "+v"(boff));
    const LAS unsigned char* ldsA = lds + aoff; const LAS unsigned char* ldsB = lds + boff;
#define G8_SA(b, h) (((b) * 2 + (h)) * HTB)
#define G8_SB(b, h) ((4 + (b) * 2 + (h)) * HTB)
#define G8_STAGE1(bufoff, rs, vo, so) __builtin_amdgcn_raw_ptr_buffer_load_lds(rs, (LAS void*)(lds + (bufoff) + ldsw), 16, (int)(vo), (int)(so), 0, 0)
#define G8_STAGE_B(bufoff, so) do { G8_STAGE1(bufoff, rB, voffB, so); G8_STAGE1((bufoff) + 8192, rB, voffB, (so) + b64); } while (0)
#define G8_STAGE_A(bufoff, rs, o, h, so) do { if constexpr (P::GATHER) { G8_STAGE1(bufoff, rs, o[2 * (h)], so); G8_STAGE1((bufoff) + 8192, rs, o[2 * (h) + 1], so); } \
        else { G8_STAGE1(bufoff, rs, o[0], (so) + (h) * 2 * a64); G8_STAGE1((bufoff) + 8192, rs, o[0], (so) + ((h) * 2 + 1) * a64); } } while (0)
#define G8_LD8(dst, base, off) do { const i32x4 _lo = *(const LAS i32x4*)((base) + (off)), _hi = *(const LAS i32x4*)((base) + (off) + 1024); dst = __builtin_shufflevector(_lo, _hi, 0, 1, 2, 3, 4, 5, 6, 7); } while (0)
#define G8_LDA(dst, b, h) do { _Pragma("unroll") for (int m = 0; m < 4; ++m) G8_LD8(dst[m], ldsA, G8_SA(b, h) + m * 2048); } while (0)
#define G8_LDB(dst, b, h) do { _Pragma("unroll") for (int n = 0; n < 2; ++n) G8_LD8(dst[n], ldsB, G8_SB(b, h) - 4 * HTB + n * 2048); } while (0)
#define G8_H(v, k) __builtin_bit_cast(bf16x8, __builtin_shufflevector(v, v, 4 * (k), 4 * (k) + 1, 4 * (k) + 2, 4 * (k) + 3))
#define G8_MMA(ai, bj, At, Bt) do { __builtin_amdgcn_s_setprio(1); \
        if constexpr (P::FP8) { _Pragma("unroll") for (int m = 0; m < 4; ++m) _Pragma("unroll") for (int n = 0; n < 2; ++n) \
            acc[ai][bj][m][n] = __builtin_amdgcn_mfma_scale_f32_16x16x128_f8f6f4(Bt[n], At[m], acc[ai][bj][m][n], 0, 0, 0, 0, 0, 0); } \
        else { _Pragma("unroll") for (int m = 0; m < 4; ++m) _Pragma("unroll") for (int n = 0; n < 2; ++n) { \
            acc[ai][bj][m][n] = __builtin_amdgcn_mfma_f32_16x16x32_bf16(G8_H(Bt[n], 0), G8_H(At[m], 0), acc[ai][bj][m][n], 0, 0, 0); \
            acc[ai][bj][m][n] = __builtin_amdgcn_mfma_f32_16x16x32_bf16(G8_H(Bt[n], 1), G8_H(At[m], 1), acc[ai][bj][m][n], 0, 0, 0); } } \
        __builtin_amdgcn_s_setprio(0); } while (0)
#define G8_WAIT_V(n) asm volatile("s_waitcnt vmcnt(" #n ")" ::: "memory")
#define G8_WAIT_L(n) asm volatile("s_waitcnt lgkmcnt(" #n ")" ::: "memory")
#define G8_BAR __builtin_amdgcn_s_barrier()
#define G8_SCHED __builtin_amdgcn_sched_barrier(0)
    typename P::Unit cur, nxt; int ui = 0;
    if (!p.next(0, cur)) return;
    i32x8 At[4], B0[2], B1[2];
    Rsrc rA, rB; int dB, a64, b64, nt; unsigned voffB; unsigned oA[P::GATHER ? 4 : 1];
    p.setup(cur, tid, rA, rB, dB, oA, voffB, a64, b64); nt = p.ntiles(cur);
    G8_STAGE_B(G8_SB(0, 0), 0); G8_STAGE_B(G8_SB(0, 1), dB); G8_STAGE_A(G8_SA(0, 0), rA, oA, 0, 0); G8_STAGE_A(G8_SA(0, 1), rA, oA, 1, 0);
    if (wr == 1) G8_BAR;
    G8_WAIT_V(2); G8_BAR;
    G8_STAGE_B(G8_SB(1, 0), 128); G8_STAGE_A(G8_SA(1, 0), rA, oA, 0, 128); G8_STAGE_B(G8_SB(1, 1), dB + 128);
    G8_WAIT_V(6); G8_BAR;
    f32x4 acc[2][2][4][2];
#pragma unroll
    for (int a = 0; a < 2; ++a)
#pragma unroll
        for (int b = 0; b < 2; ++b)
#pragma unroll
            for (int m = 0; m < 4; ++m)
#pragma unroll
                for (int n = 0; n < 2; ++n) acc[a][b][m][n] = (f32x4){0.f, 0.f, 0.f, 0.f};
    for (;;) {
        const bool has_next = p.next(ui + 1, nxt);
#pragma unroll 1
        for (int t = 0; t < nt; t += 2) {
            const bool last = (t == nt - 2);
            G8_STAGE_A(G8_SA(1, 1), rA, oA, 1, (t + 1) * 128);
            int k2 = (t + 2) * 128;
            if (last) { k2 = 0; if (has_next) p.setup(nxt, tid, rA, rB, dB, oA, voffB, a64, b64); }
            G8_LDB(B0, 0, 0); G8_LDB(B1, 0, 1); G8_SCHED; G8_LDA(At, 0, 0);
            G8_WAIT_V(8); G8_WAIT_L(0); G8_BAR; G8_MMA(0, 0, At, B0); G8_MMA(0, 1, At, B1); G8_BAR; G8_SCHED;
            G8_LDA(At, 0, 1); G8_STAGE_B(G8_SB(0, 0), k2); G8_STAGE_B(G8_SB(0, 1), dB + k2); G8_STAGE_A(G8_SA(0, 0), rA, oA, 0, k2);
            G8_WAIT_V(8); G8_WAIT_L(0); G8_BAR; G8_MMA(1, 0, At, B0); G8_MMA(1, 1, At, B1); G8_BAR; G8_SCHED;
            G8_LDB(B0, 1, 0); G8_LDB(B1, 1, 1); G8_SCHED; G8_LDA(At, 1, 0); G8_STAGE_A(G8_SA(0, 1), rA, oA, 1, k2);
            G8_WAIT_V(8); G8_WAIT_L(0); G8_BAR; G8_MMA(0, 0, At, B0); G8_MMA(0, 1, At, B1); G8_BAR; G8_SCHED;
            G8_LDA(At, 1, 1); G8_STAGE_B(G8_SB(1, 0), k2 + 128); G8_STAGE_B(G8_SB(1, 1), dB + k2 + 128); G8_STAGE_A(G8_SA(1, 0), rA, oA, 0, k2 + 128);
            G8_WAIT_V(8); G8_WAIT_L(0); G8_BAR; G8_MMA(1, 0, At, B0); G8_MMA(1, 1, At, B1); G8_BAR; G8_SCHED;
        }
        if (wr == 0) G8_BAR;
        {
            int tz = threadIdx.x; asm volatile("" : "+v"(tz));
            const int lz = tz & 63, wz = __builtin_amdgcn_readfirstlane(tz >> 6);
            p.epi(acc, cur, wz >> 2, wz & 3, lz & 15, lz >> 4);
        }
        if (!has_next) break;
        if (!p.keep_acc(cur)) {
#pragma unroll
        for (int a = 0; a < 2; ++a)
#pragma unroll
            for (int b = 0; b < 2; ++b)
#pragma unroll
                for (int m = 0; m < 4; ++m)
#pragma unroll
                    for (int n = 0; n < 2; ++n) acc[a][b][m][n] = (f32x4){0.f, 0.f, 0.f, 0.f};
        }
        cur = nxt; ++ui; nt = p.ntiles(cur);
        if (wr == 1) G8_BAR;
    }
    G8_WAIT_V(0);
    G8_BAR;
#undef G8_SA
#undef G8_SB
#undef G8_STAGE1
#undef G8_STAGE_A
#undef G8_STAGE_B
#undef G8_LDA
#undef G8_LD8
#undef G8_H
#undef G8_LDB
#undef G8_MMA
#undef G8_WAIT_V
#undef G8_WAIT_L
#undef G8_BAR
#undef G8_SCHED
}

template <int LDA_, int LDB_, int K_>
struct DenseBase {
    static constexpr int K = K_, LDA = LDA_, LDB = LDB_, LDBB = LDB_ * 2, LDAB = LDA_ * 2;
    static constexpr bool FP8 = false, GATHER = false;
    typedef Unit2 Unit;
    StaticOrder S; const bf16_t* A; const bf16_t* Bt;
    __device__ __forceinline__ bool next(int i, Unit& u) const { return S.next(i, u); }
    __device__ __forceinline__ bool keep_acc(const Unit&) const { return false; }
    __device__ __forceinline__ int ntiles(const Unit&) const { return K * 2 / 128; }
    __device__ __forceinline__ void setup(const Unit& u, int tid, Rsrc& ra, Rsrc& rb, int& db, unsigned (&o)[1], unsigned& vb, int& a64, int& b64) const {
        vb = voff_b(tid, LDBB); a64 = 64 * LDAB; b64 = 64 * LDBB;
        ra = mk_rsrc((const char*)A + (size_t)u.pm * 256 * LDA * 2);
        { int tz = tid; asm volatile("" : "+v"(tz)); int R, C; stage_rc(tz * 16, R, C); o[0] = (unsigned)(R * LDA + C) * 2u; }
        rb = mk_rsrc((const char*)Bt + (size_t)u.pn * 256 * LDB * 2); db = 128 * LDB * 2;
    }
};
}
using g8::gemm_phase;
typedef f32x4 Acc[2][2][4][2];

__device__ __forceinline__ f32x4 ld4(const float* p) { return *(const GAS f32x4*)p; }
__device__ __forceinline__ void st4(float* p, f32x4 v) { *(GAS f32x4*)p = v; }
__device__ __forceinline__ u32x4 ld16(const bf16_t* p) { return *(const GAS u32x4*)p; }
__device__ __forceinline__ void st16(bf16_t* p, u32x4 v) { *(GAS u32x4*)p = v; }
__device__ __forceinline__ u32x4 pack8(f32x4 a, f32x4 b) { u32x4 w; w.x = pk2(a[0], a[1]); w.y = pk2(a[2], a[3]); w.z = pk2(b[0], b[1]); w.w = pk2(b[2], b[3]); return w; }
__device__ __forceinline__ void unpack8(u32x4 w, f32x4& a, f32x4& b) { a = (f32x4){bflo(w.x), bfhi(w.x), bflo(w.y), bfhi(w.y)}; b = (f32x4){bflo(w.z), bfhi(w.z), bflo(w.w), bfhi(w.w)}; }

__device__ __forceinline__ u32x2 pack8_fp8(f32x4 a, f32x4 b) { int w0 = 0, w1 = 0;
#pragma unroll
    for (int j = 0; j < 4; ++j) { a[j] = __builtin_amdgcn_fmed3f(a[j], -448.0f, 448.0f); b[j] = __builtin_amdgcn_fmed3f(b[j], -448.0f, 448.0f); }
    w0 = __builtin_amdgcn_cvt_pk_fp8_f32(a[0], a[1], w0, false); w0 = __builtin_amdgcn_cvt_pk_fp8_f32(a[2], a[3], w0, true);
    w1 = __builtin_amdgcn_cvt_pk_fp8_f32(b[0], b[1], w1, false); w1 = __builtin_amdgcn_cvt_pk_fp8_f32(b[2], b[3], w1, true);
    u32x2 r; r.x = (unsigned)w0; r.y = (unsigned)w1; return r; }
__device__ __forceinline__ void st8(unsigned char* p, u32x2 v) { *(GAS u32x2*)p = v; }
__device__ __forceinline__ void unpack8_fp8(u32x2 w, f32x4& a, f32x4& b) { const f32x2 a0 = __builtin_amdgcn_cvt_pk_f32_fp8((int)w.x, false), a1 = __builtin_amdgcn_cvt_pk_f32_fp8((int)w.x, true), b0 = __builtin_amdgcn_cvt_pk_f32_fp8((int)w.y, false), b1 = __builtin_amdgcn_cvt_pk_f32_fp8((int)w.y, true);
    a = (f32x4){a0[0], a0[1], a1[0], a1[1]}; b = (f32x4){b0[0], b0[1], b1[0], b1[1]}; }
constexpr float W8_SCALE = 64.0f, ACT8_SCALE = 4.0f, YB8_SCALE = 32.0f, Y8_SCALE = 16.0f, MG8_SCALE = 64.0f;

struct DynOrder8 {
    unsigned* q; volatile LAS int* slot; int x0; mutable int quota; int nper, pn0;
    __device__ __forceinline__ bool next(int, g8::Unit2& u) const {
        if (quota <= 0) return false;
        --quota;
        if (threadIdx.x == 0) { int L = -1;
            for (int k = 0; k < 8; ++k) { const int x = (x0 + k) & 7; const unsigned v = __hip_atomic_fetch_add(q + 64 * x, 1u, __ATOMIC_RELAXED, __HIP_MEMORY_SCOPE_AGENT); if (v < (unsigned)nper) { L = (x << 16) | (int)v; break; } }
            *slot = L; }
        asm volatile("s_waitcnt lgkmcnt(0)" ::: "memory"); __builtin_amdgcn_s_barrier(); asm volatile("" ::: "memory");
        const int L = __builtin_amdgcn_readfirstlane(*slot);
        if (L < 0) return false;
        const int x = L >> 16, i = L & 0xffff; u.pm = 8 * x + (i & 7); u.pn = pn0 + (i >> 3); return true;
    }
};

__device__ __forceinline__ size_t cg_index(int row, int c) { return ((size_t)((row >> 12) * 64 + (c >> 5)) * SEQ + (row & (SEQ - 1))) * 32 + (c & 31); }

template <int MODE> struct ProbInProjT : g8::DenseBase<DM, DM, DM> {
    const float* rstd; const float* bias; bf16_t* Z; bf16_t* GG; DynOrder8 D;
    __device__ __forceinline__ bool next(int i, Unit& u) const { return D.next(i, u); }
    __device__ __forceinline__ void epi(Acc& acc, const Unit& u, int wr, int wc, int fr, int fq) const {
        if (MODE == 2) { f32x4 t = {0.f, 0.f, 0.f, 0.f};
#pragma unroll
            for (int a_ = 0; a_ < 2; ++a_)
#pragma unroll
                for (int b_ = 0; b_ < 2; ++b_)
#pragma unroll
                    for (int m_ = 0; m_ < 4; ++m_)
#pragma unroll
                        for (int n_ = 0; n_ < 2; ++n_) t += acc[a_][b_][m_][n_];
            if (t[0] + t[1] + t[2] + t[3] == 1.2345e30f) Z[0] = 1; return; }
        const int colt = u.pn * 256; const int kind = (MODE == 1) ? 0 : (colt < COL_GATE ? 0 : (colt < COL_GA ? 1 : 2));
        const int row0 = u.pm * 256 + wr * 64 + fr, col0 = colt + wc * 32 + 8 * fq;
        f32x4 bv[2][2];
#pragma unroll
        for (int bj = 0; bj < 2; ++bj) { bv[bj][0] = ld4(bias + col0 + bj * 128); bv[bj][1] = ld4(bias + col0 + bj * 128 + 4); }
        float rsv[8];
#pragma unroll
        for (int q = 0; q < 8; ++q) rsv[q] = rstd[row0 + (q >> 2) * 128 + (q & 3) * 16];
#pragma unroll
        for (int ai = 0; ai < 2; ++ai)
#pragma unroll
            for (int m = 0; m < 4; ++m) {
                const int row = row0 + ai * 128 + m * 16; const float rs = rsv[ai * 4 + m];
#pragma unroll
                for (int bj = 0; bj < 2; ++bj) {
                    f32x4 v0 = acc[ai][bj][m][0] * rs + bv[bj][0], v1 = acc[ai][bj][m][1] * rs + bv[bj][1];
                    if (colt < COL_K) { v0 *= QK_SCALE; v1 *= QK_SCALE; }
                    if (kind == 1) {
#pragma unroll
                        for (int j = 0; j < 4; ++j) { v0[j] = gelu_tanh(v0[j]); v1[j] = gelu_tanh(v1[j]); }
                    } else if (kind == 2) {
#pragma unroll
                        for (int j = 0; j < 4; ++j) { v0[j] = fsigmoid(v0[j]); v1[j] = fsigmoid(v1[j]); }
                    }
#ifdef P1_NT
                    if (kind == 1) __builtin_nontemporal_store(pack8(v0, v1), (GAS u32x4*)(GG + cg_index(row, col0 + bj * 128 - COL_GATE)));
                    else __builtin_nontemporal_store(pack8(v0, v1), (GAS u32x4*)(Z + (size_t)row * INW + col0 + bj * 128));
#else
                    if (kind == 1) st16(GG + cg_index(row, col0 + bj * 128 - COL_GATE), pack8(v0, v1));
                    else st16(Z + (size_t)row * INW + col0 + bj * 128, pack8(v0, v1));
#endif
                }
            }
    }
};

typedef ProbInProjT<0> ProbInProj;

constexpr float X8_SCALE = 8.0f;
constexpr int PN_GA = PN8_FIRST, COL8 = PN8_FIRST * 256, NCOL8 = INW - COL8;
struct ProbInProj8 {
    static constexpr bool FP8 = true, GATHER = false;
    typedef g8::Unit2 Unit;
    const unsigned char *XQ, *W8; const float* rstd; const float* bias; bf16_t* Z; bf16_t* GG; DynOrder8 D;
    __device__ __forceinline__ bool next(int i, Unit& u) const { return D.next(i, u); }
    __device__ __forceinline__ bool keep_acc(const Unit&) const { return false; }
    __device__ __forceinline__ int ntiles(const Unit&) const { return DM / 128; }
    __device__ __forceinline__ void setup(const Unit& u, int tid, g8::Rsrc& ra, g8::Rsrc& rb, int& db, unsigned (&o)[1], unsigned& vb, int& a64, int& b64) const {
        vb = g8::voff_b(tid, DM); a64 = 64 * DM; b64 = 64 * DM;
        ra = g8::mk_rsrc((const char*)XQ + (size_t)u.pm * 256 * DM);
        { int tz = tid; asm volatile("" : "+v"(tz)); int R, C; g8::stage_rc(tz * 16, R, C); o[0] = (unsigned)(R * DM + C * 2); }
        rb = g8::mk_rsrc((const char*)W8 + (size_t)(u.pn - PN_GA) * 256 * DM); db = 128 * DM;
    }
    __device__ __forceinline__ void epi(Acc& acc, const Unit& u, int wr, int wc, int fr, int fq) const {
        const int colt = u.pn * 256; const int row0 = u.pm * 256 + wr * 64 + fr, col0 = colt + wc * 32 + 8 * fq;
        const int kind = colt < COL_GATE ? 0 : (colt < COL_GA ? 1 : 2);
        f32x4 bv[2][2];
#pragma unroll
        for (int bj = 0; bj < 2; ++bj) { bv[bj][0] = ld4(bias + col0 + bj * 128); bv[bj][1] = ld4(bias + col0 + bj * 128 + 4); }
        float rsv[8];
#pragma unroll
        for (int q = 0; q < 8; ++q) rsv[q] = rstd[row0 + (q >> 2) * 128 + (q & 3) * 16] * (1.0f / (X8_SCALE * W8_SCALE));
#pragma unroll
        for (int ai = 0; ai < 2; ++ai)
#pragma unroll
            for (int m = 0; m < 4; ++m) {
                const int row = row0 + ai * 128 + m * 16; const float rs = rsv[ai * 4 + m];
#pragma unroll
                for (int bj = 0; bj < 2; ++bj) {
                    f32x4 v0 = acc[ai][bj][m][0] * rs + bv[bj][0], v1 = acc[ai][bj][m][1] * rs + bv[bj][1];
                    if (colt < COL_K) { v0 *= QK_SCALE; v1 *= QK_SCALE; }
                    if (kind == 1) {
#pragma unroll
                        for (int j = 0; j < 4; ++j) { v0[j] = gelu_tanh(v0[j]); v1[j] = gelu_tanh(v1[j]); }
                    } else if (kind == 2) {
#pragma unroll
                        for (int j = 0; j < 4; ++j) { v0[j] = fsigmoid(v0[j]); v1[j] = fsigmoid(v1[j]); }
                    }
                    if (kind == 1) st16(GG + cg_index(row, col0 + bj * 128 - COL_GATE), pack8(v0, v1));
                    else st16(Z + (size_t)row * INW + col0 + bj * 128, pack8(v0, v1));
                }
            }
    }
};

struct UnitG { int pm, n, ch; };
struct ProbGates {
    static constexpr int K = 256, LDBB = 512, LDAB = DM * 2;
    static constexpr bool FP8 = false, GATHER = false;
    typedef UnitG Unit;
    __device__ __forceinline__ bool keep_acc(const Unit&) const { return false; }
    int G, c; const bf16_t* UC; const bf16_t* W; const float *b_a, *b_x, *lam; bf16_t* LA2; bf16_t* XIN;
    __device__ __forceinline__ bool next(int i, Unit& u) const { const int L = i * G + c; if (L >= 1024) return false; u.ch = L & 1; u.n = (L >> 1) & 7; u.pm = L >> 4; return true; }
    __device__ __forceinline__ int ntiles(const Unit&) const { return K * 2 / 128; }
    __device__ __forceinline__ void setup(const Unit& u, int tid, g8::Rsrc& ra, g8::Rsrc& rb, int& db, unsigned (&o)[1], unsigned& vb, int& a64, int& b64) const {
        vb = g8::voff_b(tid, LDBB); a64 = 64 * LDAB; b64 = 64 * LDBB;
        ra = g8::mk_rsrc((const char*)UC + ((size_t)u.pm * 256 * DM + u.n * 256) * 2);
        { int tz = tid; asm volatile("" : "+v"(tz)); int R, C; g8::stage_rc(tz * 16, R, C); o[0] = (unsigned)(R * DM + C) * 2u; }
        rb = g8::mk_rsrc((const char*)W + ((size_t)(u.n * 256 + u.ch * 128) * 256) * 2); db = 8 * 256 * 256 * 2;
    }
    __device__ __forceinline__ void epi(Acc& acc, const Unit& u, int wr, int wc, int fr, int fq) const {
        const int ch0 = u.n * 256 + u.ch * 128 + wc * 32 + 8 * fq;
        const int row0 = u.pm * 256 + wr * 64 + fr;
        f32x4 ba[2], bx[2], sp[2];
#pragma unroll
        for (int n = 0; n < 2; ++n) { ba[n] = ld4(b_a + ch0 + 4 * n); bx[n] = ld4(b_x + ch0 + 4 * n); const f32x4 l = ld4(lam + ch0 + 4 * n);
#pragma unroll
            for (int j = 0; j < 4; ++j) { const float z = -l[j]; sp[n][j] = (z > 15.f) ? z : log1pf(__expf(z)); } }
        u32x4 ucv[8];
#pragma unroll
        for (int q = 0; q < 8; ++q) ucv[q] = ld16(UC + (size_t)(row0 + (q >> 2) * 128 + (q & 3) * 16) * DM + ch0);
#pragma unroll
        for (int ai = 0; ai < 2; ++ai)
#pragma unroll
            for (int m = 0; m < 4; ++m) {
                const int row = row0 + ai * 128 + m * 16; const bool first = (row & (SEQ - 1)) == 0;
                f32x4 uc0, uc1; unpack8(ucv[ai * 4 + m], uc0, uc1);
                f32x4 av[2], xv[2];
#pragma unroll
                for (int n = 0; n < 2; ++n)
#pragma unroll
                    for (int j = 0; j < 4; ++j) {
                        const float ea = 1.0f + __builtin_amdgcn_exp2f(-1.4426950409f * (acc[ai][0][m][n][j] + ba[n][j])), ex = 1.0f + __builtin_amdgcn_exp2f(-1.4426950409f * (acc[ai][1][m][n][j] + bx[n][j]));
                        const float tt = __builtin_amdgcn_rcpf(ea * ex); const float r = tt * ex, ig = tt * ea;
                        const float la = -8.0f * r * sp[n][j];
                        const float x2 = 2.0f * la; const float em = (x2 > -0.5f) ? -x2 * (1.0f + x2 * (0.5f + x2 * (0.16666667f + x2 * (0.041666668f + x2 * (0.0083333338f + x2 * 0.0013888889f))))) : 1.0f - __expf(x2);
                        const float mult = first ? 1.0f : __builtin_amdgcn_sqrtf(em);
                        av[n][j] = la * 1.4426950409f; xv[n][j] = mult * ig * (n == 0 ? uc0[j] : uc1[j]);
                    }
                const size_t o = cg_index(row, ch0);
                st16(LA2 + o, pack8(av[0], av[1])); st16(XIN + o, pack8(xv[0], xv[1]));
                __builtin_amdgcn_sched_barrier(0);
            }
    }
};

struct UnitP { int pm, pn, part; };
struct ProbProj2 {
    static constexpr int K = DM, LDBB = DM, LDAB = DM;
    static constexpr bool FP8 = true, GATHER = false;
    typedef UnitP Unit;
    g8::StaticOrder S; const bf16_t *YA, *YL, *WA, *WL, *Z; bf16_t* MG;
    __device__ __forceinline__ bool next(int i, Unit& u) const { g8::Unit2 t; if (!S.next(i >> 1, t)) return false; u.pm = t.pm; u.pn = t.pn; u.part = i & 1; return true; }
    __device__ __forceinline__ bool keep_acc(const Unit& u) const { return u.part == 0; }
    __device__ __forceinline__ int ntiles(const Unit&) const { return K / 128; }
    __device__ __forceinline__ void setup(const Unit& u, int tid, g8::Rsrc& ra, g8::Rsrc& rb, int& db, unsigned (&o)[1], unsigned& vb, int& a64, int& b64) const {
        vb = g8::voff_b(tid, LDBB); a64 = 64 * LDAB; b64 = 64 * LDBB;
        ra = g8::mk_rsrc((const char*)(u.part ? YL : YA) + (size_t)u.pm * 256 * DM);
        { int tz = tid; asm volatile("" : "+v"(tz)); int R, C; g8::stage_rc(tz * 16, R, C); o[0] = (unsigned)(R * DM + C * 2); }
        rb = g8::mk_rsrc((const char*)(u.part ? WL : WA) + (size_t)u.pn * 256 * DM); db = 128 * DM;
    }
    __device__ __forceinline__ void epi(Acc& acc, const Unit& u, int wr, int wc, int fr, int fq) const {
        const int row0 = u.pm * 256 + wr * 64 + fr, col0 = u.pn * 256 + wc * 32 + 8 * fq;
        if (u.part == 0) {
#pragma unroll
            for (int ai = 0; ai < 2; ++ai)
#pragma unroll
                for (int m = 0; m < 4; ++m) {
                    const int row = row0 + ai * 128 + m * 16;
#pragma unroll
                    for (int bj = 0; bj < 2; ++bj) {
                        const int col = col0 + bj * 128;
                        f32x4 l0, l1, a0, a1; unpack8(ld16(Z + (size_t)row * INW + COL_GL + col), l0, l1); unpack8(ld16(Z + (size_t)row * INW + COL_GA + col), a0, a1);
#pragma unroll
                        for (int j = 0; j < 4; ++j) { acc[ai][bj][m][0][j] *= a0[j] * __builtin_amdgcn_rcpf(l0[j]); acc[ai][bj][m][1][j] *= a1[j] * __builtin_amdgcn_rcpf(l1[j]); }
                    }
                }
        } else {
            u32x4 gl[8][2];
#pragma unroll
            for (int q = 0; q < 8; ++q)
#pragma unroll
                for (int bj = 0; bj < 2; ++bj) gl[q][bj] = ld16(Z + (size_t)(row0 + (q >> 2) * 128 + (q & 3) * 16) * INW + COL_GL + col0 + bj * 128);
#pragma unroll
            for (int ai = 0; ai < 2; ++ai)
#pragma unroll
                for (int m = 0; m < 4; ++m) {
                    const int row = row0 + ai * 128 + m * 16;
#pragma unroll
                    for (int bj = 0; bj < 2; ++bj) { f32x4 l0, l1; unpack8(gl[ai * 4 + m][bj], l0, l1);
                        st8((unsigned char*)MG + (size_t)row * DM + col0 + bj * 128, pack8_fp8(acc[ai][bj][m][0] * (l0 * (MG8_SCALE / (Y8_SCALE * W8_SCALE))), acc[ai][bj][m][1] * (l1 * (MG8_SCALE / (Y8_SCALE * W8_SCALE))))); }
                }
        }
    }
};

struct ProbOut {
    static constexpr bool FP8 = true, GATHER = false;
    typedef g8::Unit2 Unit;
    g8::StaticOrder S; const bf16_t* A; const bf16_t* Bt;
    __device__ __forceinline__ bool next(int i, Unit& u) const { return S.next(i, u); }
    __device__ __forceinline__ bool keep_acc(const Unit&) const { return false; }
    __device__ __forceinline__ int ntiles(const Unit&) const { return DM / 128; }
    __device__ __forceinline__ void setup(const Unit& u, int tid, g8::Rsrc& ra, g8::Rsrc& rb, int& db, unsigned (&o)[1], unsigned& vb, int& a64, int& b64) const {
        vb = g8::voff_b(tid, DM); a64 = 64 * DM; b64 = 64 * DM;
        ra = g8::mk_rsrc((const char*)A + (size_t)u.pm * 256 * DM);
        { int tz = tid; asm volatile("" : "+v"(tz)); int R, C; g8::stage_rc(tz * 16, R, C); o[0] = (unsigned)(R * DM + C * 2); }
        rb = g8::mk_rsrc((const char*)Bt + (size_t)u.pn * 256 * DM); db = 128 * DM;
    }
    const float* X; float* H1; unsigned char* H1Q;
    __device__ __forceinline__ void epi(Acc& acc, const Unit& u, int wr, int wc, int fr, int fq) const {
        const int row0 = u.pm * 256 + wr * 64 + fr, col0 = u.pn * 256 + wc * 32 + 8 * fq;
        f32x4 xn[4];
#pragma unroll
        for (int t = 0; t < 4; ++t) xn[t] = ld4(X + (size_t)row0 * DM + col0 + (t >> 1) * 128 + (t & 1) * 4);
#pragma unroll
        for (int q = 0; q < 8; ++q) {
            const int ai = q >> 2, m = q & 3; const int row = row0 + ai * 128 + m * 16;
            f32x4 xc[4];
#pragma unroll
            for (int t = 0; t < 4; ++t) xc[t] = xn[t];
            if (q < 7) { const int rn = row0 + ((q + 1) >> 2) * 128 + ((q + 1) & 3) * 16;
#pragma unroll
                for (int t = 0; t < 4; ++t) xn[t] = ld4(X + (size_t)rn * DM + col0 + (t >> 1) * 128 + (t & 1) * 4); }
#pragma unroll
            for (int bj = 0; bj < 2; ++bj) {
                const size_t o = (size_t)row * DM + col0 + bj * 128;
                const f32x4 v0 = acc[ai][bj][m][0] * (1.0f / (MG8_SCALE * W8_SCALE)) + xc[2 * bj], v1 = acc[ai][bj][m][1] * (1.0f / (MG8_SCALE * W8_SCALE)) + xc[2 * bj + 1];
                st4(H1 + o, v0); st4(H1 + o + 4, v1); st8(H1Q + o, pack8_fp8(v0, v1));
            }
        }
    }
};

struct UnitM { int e, rt, ct, cnt, base; };
template <int NCT_LOG2>
__device__ __forceinline__ bool moe_next(const volatile LAS int* tab, int i, int G, int c, UnitM& u) {
    int ct, g;
    if (G == 256) { const int x = c & 7, j = c >> 3;
        if (NCT_LOG2 == 4) { ct = 4 * (x & 3) + (j & 3); g = i * 16 + 8 * (x >> 2) + (j >> 2); }
        else { ct = 4 * (x & 1) + (j & 3); g = i * 32 + 8 * (x >> 1) + (j >> 2); } }
    else { const int L = i * G + c; ct = L & ((1 << NCT_LOG2) - 1); g = L >> NCT_LOG2; }
    if (g >= __builtin_amdgcn_readfirstlane(tab[32])) return false;
    const int e = __builtin_amdgcn_readfirstlane((int)((const volatile LAS unsigned char*)tab)[576 + g]);
    u.e = e; u.rt = g - __builtin_amdgcn_readfirstlane(tab[e]); u.ct = ct; u.base = __builtin_amdgcn_readfirstlane(tab[33 + e]); u.cnt = __builtin_amdgcn_readfirstlane(tab[33 + e + 1]) - u.base; return true;
}
struct ProbMoe1 {
    static constexpr int K = DM, LDBB = DM, LDAB = DM;
    static constexpr bool FP8 = true, GATHER = true;
    typedef UnitM Unit;
    __device__ __forceinline__ bool keep_acc(const Unit&) const { return false; }
    int G, c; const volatile LAS int* tab; const unsigned char* H1Q; const unsigned char* W1; const int* elist; const float* rstd2; const float* prs; const float* b1; unsigned char* ACT;
    __device__ __forceinline__ bool next(int i, Unit& u) const { return moe_next<4>(tab, i, G, c, u); }
    __device__ __forceinline__ int ntiles(const Unit&) const { return K / 128; }
    __device__ __forceinline__ void setup(const Unit& u, int tid, g8::Rsrc& ra, g8::Rsrc& rb, int& db, unsigned (&o)[4], unsigned& vb, int& a64, int& b64) const {
        vb = g8::voff_b(tid, LDBB); a64 = 64 * LDAB; b64 = 64 * LDBB;
        ra = g8::mk_rsrc(H1Q); const int* el = elist + (size_t)u.e * NTOK;
        int tz = tid; asm volatile("" : "+v"(tz));
        int R, C; g8::stage_rc(tz * 16, R, C);
#pragma unroll
        for (int q = 0; q < 4; ++q) { const int pq = u.rt * 256 + R + 64 * (q & 1) + 128 * (q >> 1); const int sq = el[pq < u.cnt ? pq : 0] & 0xffff; o[q] = (unsigned)((sq >> 2) * DM + C * 2); }
        rb = g8::mk_rsrc((const char*)W1 + ((size_t)u.e * 2 * DFF + u.ct * 128) * DM); db = DFF * DM;
    }
    __device__ __forceinline__ void epi(Acc& acc, const Unit& u, int wr, int wc, int fr, int fq) const {
        const int gc = u.ct * 128 + wc * 32 + 8 * fq; const float* bb = b1 + (size_t)u.e * 2 * DFF;
        const f32x4 bg0 = ld4(bb + gc), bg1 = ld4(bb + gc + 4), bl0 = ld4(bb + DFF + gc), bl1 = ld4(bb + DFF + gc + 4);
        const int* el = elist + (size_t)u.e * NTOK;
#pragma unroll
        for (int ai = 0; ai < 2; ++ai) {
            float rsv[4];
#pragma unroll
            for (int q = 0; q < 4; ++q) { const int pos = u.rt * 256 + ai * 128 + wr * 64 + q * 16 + fr; rsv[q] = prs[(size_t)u.e * NTOK + (pos < u.cnt ? pos : 0)] * (1.0f / W8_SCALE); }
#pragma unroll
            for (int m = 0; m < 4; ++m) {
                const int pos = u.rt * 256 + ai * 128 + wr * 64 + m * 16 + fr; const float rs = rsv[m];
                f32x4 g0 = acc[ai][0][m][0] * rs + bg0, g1 = acc[ai][0][m][1] * rs + bg1, l0 = acc[ai][1][m][0] * rs + bl0, l1 = acc[ai][1][m][1] * rs + bl1;
#pragma unroll
                for (int j = 0; j < 4; ++j) {
                    float g = fminf(g0[j], 7.0f), l = fminf(fmaxf(l0[j], -7.0f), 7.0f); g0[j] = g * fsigmoid(1.702f * g) * (l + 1.0f) * ACT8_SCALE;
                    g = fminf(g1[j], 7.0f); l = fminf(fmaxf(l1[j], -7.0f), 7.0f); g1[j] = g * fsigmoid(1.702f * g) * (l + 1.0f) * ACT8_SCALE;
                }
                if (pos < u.cnt) st8(ACT + (size_t)(u.base + pos) * DFF + gc, pack8_fp8(g0, g1));
            }
        }
    }
};
template <int STUB> struct ProbMoe2T {
    static constexpr int K = DFF, LDBB = DFF, LDAB = DFF;
    static constexpr bool FP8 = true, GATHER = false;
    typedef UnitM Unit;
    __device__ __forceinline__ bool keep_acc(const Unit&) const { return false; }
    int G, c; const volatile LAS int* tab; const unsigned char* ACT; const unsigned char* W2; const int* elist; const float* topw; const float* pw; const float* b2; unsigned char* YB;
    __device__ __forceinline__ bool next(int i, Unit& u) const { return moe_next<3>(tab, i, G, c, u); }
    __device__ __forceinline__ int ntiles(const Unit&) const { return K / 128; }
    __device__ __forceinline__ void setup(const Unit& u, int tid, g8::Rsrc& ra, g8::Rsrc& rb, int& db, unsigned (&o)[1], unsigned& vb, int& a64, int& b64) const {
        vb = g8::voff_b(tid, LDBB); a64 = 64 * LDAB; b64 = 64 * LDBB;
        ra = g8::mk_rsrc((const char*)ACT + (size_t)(u.base + u.rt * 256) * DFF);
        { int tz = tid; asm volatile("" : "+v"(tz)); int R, C; g8::stage_rc(tz * 16, R, C); o[0] = (unsigned)(R * DFF + C * 2); }
        rb = g8::mk_rsrc((const char*)W2 + ((size_t)u.e * DM + u.ct * 256) * DFF); db = 128 * DFF;
    }
    __device__ __forceinline__ void epi(Acc& acc, const Unit& u, int wr, int wc, int fr, int fq) const {
        if (STUB) { f32x4 t = {0.f, 0.f, 0.f, 0.f};
#pragma unroll
            for (int a_ = 0; a_ < 2; ++a_)
#pragma unroll
                for (int b_ = 0; b_ < 2; ++b_)
#pragma unroll
                    for (int m_ = 0; m_ < 4; ++m_)
#pragma unroll
                        for (int n_ = 0; n_ < 2; ++n_) t += acc[a_][b_][m_][n_];
            if (t[0] + t[1] + t[2] + t[3] == 1.2345e30f) YB[0] = 1; return; }
        const int col0 = u.ct * 256 + wc * 32 + 8 * fq; const float* bb = b2 + (size_t)u.e * DM;
        f32x4 bv[2][2];
#pragma unroll
        for (int bj = 0; bj < 2; ++bj) { bv[bj][0] = ld4(bb + col0 + bj * 128); bv[bj][1] = ld4(bb + col0 + bj * 128 + 4); }
        const int* el = elist + (size_t)u.e * NTOK;
#pragma unroll
        for (int ai = 0; ai < 2; ++ai) {
            int slot[4]; float wv[4];
#pragma unroll
            for (int q = 0; q < 4; ++q) { const int pos = u.rt * 256 + ai * 128 + wr * 64 + q * 16 + fr; slot[q] = el[pos < u.cnt ? pos : 0] & 0xffff; }
#pragma unroll
            for (int q = 0; q < 4; ++q) { const int pos = u.rt * 256 + ai * 128 + wr * 64 + q * 16 + fr; wv[q] = pw[(size_t)u.e * NTOK + (pos < u.cnt ? pos : 0)] * YB8_SCALE; }
#pragma unroll
            for (int m = 0; m < 4; ++m) {
                const int pos = u.rt * 256 + ai * 128 + wr * 64 + m * 16 + fr; const float w = wv[m]; const int sl = slot[m];
                if (pos < u.cnt) {
#pragma unroll
                    for (int bj = 0; bj < 2; ++bj)
                        st8(YB + (size_t)sl * DM + col0 + bj * 128, pack8_fp8((acc[ai][bj][m][0] * (1.0f / (W8_SCALE * ACT8_SCALE)) + bv[bj][0]) * w, (acc[ai][bj][m][1] * (1.0f / (W8_SCALE * ACT8_SCALE)) + bv[bj][1]) * w));
                }
            }
        }
    }
};
typedef ProbMoe2T<0> ProbMoe2;

struct ProbPle : g8::DenseBase<PLE, PLE, PLE> {
    bf16_t* PE;
    __device__ __forceinline__ void epi(Acc& acc, const Unit& u, int wr, int wc, int fr, int fq) const {
        const int row0 = u.pm * 256 + wr * 64 + fr, col0 = u.pn * 256 + wc * 32 + 8 * fq;
#pragma unroll
        for (int ai = 0; ai < 2; ++ai)
#pragma unroll
            for (int m = 0; m < 4; ++m)
#pragma unroll
                for (int bj = 0; bj < 2; ++bj) st16(PE + (size_t)(row0 + ai * 128 + m * 16) * DM + col0 + bj * 128, pack8(acc[ai][bj][m][0], acc[ai][bj][m][1]));
    }
};
struct ProbGate8 {
    static constexpr bool FP8 = true, GATHER = false;
    typedef g8::Unit2 Unit;
    g8::StaticOrder S; const unsigned char *H2Q, *WPG8; const bf16_t *H2B, *PE; const float* rstd3; bf16_t* H3B; float* SS3;
    __device__ __forceinline__ bool next(int i, Unit& u) const { return S.next(i, u); }
    __device__ __forceinline__ bool keep_acc(const Unit&) const { return false; }
    __device__ __forceinline__ int ntiles(const Unit&) const { return DM / 128; }
    __device__ __forceinline__ void setup(const Unit& u, int tid, g8::Rsrc& ra, g8::Rsrc& rb, int& db, unsigned (&o)[1], unsigned& vb, int& a64, int& b64) const {
        vb = g8::voff_b(tid, DM); a64 = 64 * DM; b64 = 64 * DM;
        ra = g8::mk_rsrc((const char*)H2Q + (size_t)u.pm * 256 * DM);
        { int tz = tid; asm volatile("" : "+v"(tz)); int R, C; g8::stage_rc(tz * 16, R, C); o[0] = (unsigned)(R * DM + C * 2); }
        rb = g8::mk_rsrc((const char*)WPG8 + (size_t)u.pn * 256 * DM); db = 128 * DM;
    }
    __device__ __forceinline__ void epi(Acc& acc, const Unit& u, int wr, int wc, int fr, int fq) const {
        const int row0 = u.pm * 256 + wr * 64 + fr, col0 = u.pn * 256 + wc * 32 + 8 * fq;
        float rsv[8];
#pragma unroll
        for (int q = 0; q < 8; ++q) rsv[q] = rstd3[row0 + (q >> 2) * 128 + (q & 3) * 16] * (1.0f / W8_SCALE);
        u32x4 pn[2], hn[2];
#pragma unroll
        for (int bj = 0; bj < 2; ++bj) { const size_t o = (size_t)row0 * DM + col0 + bj * 128; pn[bj] = ld16(PE + o); hn[bj] = ld16(H2B + o); }
#pragma unroll
        for (int q = 0; q < 8; ++q) {
            const int ai = q >> 2, m = q & 3; const int row = row0 + ai * 128 + m * 16; const float rs = rsv[q];
            u32x4 pc[2], hc[2];
#pragma unroll
            for (int t = 0; t < 2; ++t) { pc[t] = pn[t]; hc[t] = hn[t]; }
            if (q < 7) { const int rn = row0 + ((q + 1) >> 2) * 128 + ((q + 1) & 3) * 16;
#pragma unroll
                for (int bj = 0; bj < 2; ++bj) { const size_t o = (size_t)rn * DM + col0 + bj * 128; pn[bj] = ld16(PE + o); hn[bj] = ld16(H2B + o); } }
            float ss = 0.f;
#pragma unroll
            for (int bj = 0; bj < 2; ++bj) {
                const size_t o = (size_t)row * DM + col0 + bj * 128;
                f32x4 pe[2], h[2], v[2]; unpack8(pc[bj], pe[0], pe[1]); unpack8(hc[bj], h[0], h[1]);
#pragma unroll
                for (int n = 0; n < 2; ++n)
#pragma unroll
                    for (int j = 0; j < 4; ++j) { v[n][j] = h[n][j] + fsigmoid(acc[ai][bj][m][n][j] * rs) * pe[n][j]; ss += v[n][j] * v[n][j]; }
                st16(H3B + o, pack8(v[0], v[1]));
            }
            ss += __shfl_xor(ss, 16); ss += __shfl_xor(ss, 32);
            if (fq == 0) SS3[(size_t)row * 32 + u.pn * 4 + wc] = ss;
        }
    }
};

__device__ __forceinline__ void tr_item(const float* W, int N, bf16_t* WT, int K, const float* scale, int kb, int nb, LAS float* scr, int lane) {
    const int k0 = kb * 64, n0 = nb * 64, lr = lane >> 4, lc = (lane & 15) * 4;
    f32x4 v[16];
#pragma unroll
    for (int i = 0; i < 16; ++i) v[i] = __builtin_nontemporal_load((const GAS f32x4*)(W + (size_t)(k0 + 4 * i + lr) * N + n0 + lc));
#pragma unroll
    for (int i = 0; i < 16; ++i) { const int kk = 4 * i + lr; const float sc = scale ? scale[k0 + kk] : 1.0f;
        scr[kk * 65 + lc + 0] = v[i][0] * sc; scr[kk * 65 + lc + 1] = v[i][1] * sc; scr[kk * 65 + lc + 2] = v[i][2] * sc; scr[kk * 65 + lc + 3] = v[i][3] * sc; }
    LDS_WAIT();
    const int c = lane & 7;
#pragma unroll
    for (int j = 0; j < 8; ++j) { const int n = (lane >> 3) + 8 * j; const LAS float* s = scr + (8 * c) * 65 + n;
        u32x4 o; o.x = pk2(s[0 * 65], s[1 * 65]); o.y = pk2(s[2 * 65], s[3 * 65]); o.z = pk2(s[4 * 65], s[5 * 65]); o.w = pk2(s[6 * 65], s[7 * 65]);
        st16(WT + (size_t)(n0 + n) * K + k0 + 8 * c, o); }
    LDS_WAIT();
}

struct TrJob { const float* W; unsigned char* WQ; const float* scale; int N, K, kb, nb; };
struct TrRegs { f32x4 v[16]; float sc[16]; };
__device__ __forceinline__ void tr8_load(const TrJob& j, TrRegs& r, float mul, int lane) {
    const int k0 = j.kb * 128, n0 = j.nb * 32, lr = lane >> 3, lc = (lane & 7) * 4;
#pragma unroll
    for (int i = 0; i < 16; ++i) r.sc[i] = j.scale ? j.scale[k0 + 8 * i + lr] * mul : mul;
#pragma unroll
#ifdef CONV_PLAIN_LD
    for (int i = 0; i < 16; ++i) r.v[i] = *(const GAS f32x4*)(j.W + (size_t)(k0 + 8 * i + lr) * j.N + n0 + lc);
#else
    for (int i = 0; i < 16; ++i) r.v[i] = __builtin_nontemporal_load((const GAS f32x4*)(j.W + (size_t)(k0 + 8 * i + lr) * j.N + n0 + lc));
#endif
}
__device__ __forceinline__ void tr8_finish(const TrJob& j, const TrRegs& r, LAS float* scr, int lane) {
    const int k0 = j.kb * 128, n0 = j.nb * 32, lr = lane >> 3, lc = (lane & 7) * 4;
#pragma unroll
    for (int i = 0; i < 16; ++i) { const int kk = 8 * i + lr; const f32x4 t = r.v[i] * r.sc[i];
        scr[(lc + 0) * 130 + kk] = t[0]; scr[(lc + 1) * 130 + kk] = t[1]; scr[(lc + 2) * 130 + kk] = t[2]; scr[(lc + 3) * 130 + kk] = t[3]; }
    LDS_WAIT();
    const int c = lane & 7;
#pragma unroll
    for (int jj = 0; jj < 4; ++jj) { const int n = (lane >> 3) + 8 * jj; const LAS f32x2* sp = (const LAS f32x2*)(scr + n * 130 + 16 * c);
        u32x4 o;
#pragma unroll
        for (int q = 0; q < 4; ++q) { const f32x2 p0 = sp[2 * q], p1 = sp[2 * q + 1]; int w = 0; w = __builtin_amdgcn_cvt_pk_fp8_f32(p0[0], p0[1], w, false); w = __builtin_amdgcn_cvt_pk_fp8_f32(p1[0], p1[1], w, true); o[q] = (unsigned)w; }
        __builtin_nontemporal_store(o, (GAS u32x4*)(j.WQ + (size_t)(n0 + n) * j.K + k0 + 16 * c)); }
    LDS_WAIT();
}
constexpr int I_W1 = 32 * 16 * 128, I_W2 = 32 * 16 * 64, I_MOE = I_W1 + I_W2;
__device__ __forceinline__ TrJob moe_job(const float* w1, const float* w2, const float* gffn, unsigned char* ws, int it) {
    TrJob j;
    if (it < I_W1) { const int e = it >> 11, q = it & 2047; j.W = w1 + (size_t)e * DM * 2 * DFF; j.N = 2 * DFF; j.WQ = ws + WS_W1 + (size_t)e * 2 * DFF * DM; j.K = DM; j.scale = gffn; j.kb = q >> 7; j.nb = q & 127; }
    else { const int r = it - I_W1, e = r >> 10, q = r & 1023; j.W = w2 + (size_t)e * DFF * DM; j.N = DM; j.WQ = ws + WS_W2 + (size_t)e * DM * DFF; j.K = DFF; j.scale = nullptr; j.kb = q >> 6; j.nb = q & 63; }
    return j;
}
constexpr int NB_W1 = 32 * 16 * 32, NB_W2 = 32 * 16 * 16, NB_MOE = NB_W1 + NB_W2;
struct BlkJob { const float* W; unsigned char* WQ; const float* scale; int N, K, kb, nb, use_scale; };
constexpr int NB_PG = 16 * 16, NB_ALL = NB_MOE + 4 * NB_PG, NB_IN8 = 16 * ((INW - PN8_FIRST * 256) / 128);
__device__ __forceinline__ BlkJob moe_blk(const float* w1, const float* w2, const float* gffn, unsigned char* ws, int it, const float* wpg, const float* gple, const float* win, const float* gmix, const float* wap, const float* wlp, const float* wout) {
    BlkJob j;
    if (it >= NB_ALL) { const int q = it - NB_ALL; constexpr int NNB = (INW - PN8_FIRST * 256) / 128; j.W = win + PN8_FIRST * 256; j.N = INW; j.WQ = ws + WS_WIN8; j.K = DM; j.scale = gmix; j.use_scale = 1; j.kb = q / NNB; j.nb = q % NNB; }
    else if (it >= NB_MOE + 3 * NB_PG) { const int q = it - NB_MOE - 3 * NB_PG; j.W = wout; j.N = DM; j.WQ = ws + WS_WOUT; j.K = DM; j.scale = gple; j.use_scale = 0; j.kb = q >> 4; j.nb = q & 15; }
    else if (it >= NB_MOE + 2 * NB_PG) { const int q = it - NB_MOE - 2 * NB_PG; j.W = wlp; j.N = DM; j.WQ = ws + WS_WLP; j.K = DM; j.scale = gple; j.use_scale = 0; j.kb = q >> 4; j.nb = q & 15; }
    else if (it >= NB_MOE + NB_PG) { const int q = it - NB_MOE - NB_PG; j.W = wap; j.N = DM; j.WQ = ws + WS_WAP; j.K = DM; j.scale = gple; j.use_scale = 0; j.kb = q >> 4; j.nb = q & 15; }
    else if (it >= NB_MOE) { const int q = it - NB_MOE; j.W = wpg; j.N = DM; j.WQ = ws + WS_WPG; j.K = DM; j.scale = gple; j.use_scale = 1; j.kb = q >> 4; j.nb = q & 15; }
    else if (it < NB_W1) { const int e = it >> 9, q = it & 511; j.W = w1 + (size_t)e * DM * 2 * DFF; j.N = 2 * DFF; j.WQ = ws + WS_W1 + (size_t)e * 2 * DFF * DM; j.K = DM; j.scale = gffn; j.use_scale = 1; j.kb = q >> 5; j.nb = q & 31; }
    else { const int r = it - NB_W1, e = r >> 8, q = r & 255; j.W = w2 + (size_t)e * DFF * DM; j.N = DM; j.WQ = ws + WS_W2 + (size_t)e * DM * DFF; j.K = DFF; j.scale = gffn; j.use_scale = 0; j.kb = q >> 4; j.nb = q & 15; }
    return j;
}
__device__ __forceinline__ void blk_load(const BlkJob& j, f32x4 (&v)[8], float (&sc)[8], int wave, int lane) {
    const int kr = 16 * wave + (lane >> 5), g = lane & 31;
#pragma unroll
    for (int i = 0; i < 8; ++i) { const float g = j.scale[j.kb * 128 + kr + 2 * i]; sc[i] = (j.use_scale ? g : 1.0f) * W8_SCALE; }
#pragma unroll
    for (int i = 0; i < 8; ++i) v[i] = __builtin_nontemporal_load((const GAS f32x4*)(j.W + (size_t)(j.kb * 128 + kr + 2 * i) * j.N + j.nb * 128 + 4 * g));
}
__device__ __forceinline__ void blk_put(const f32x4 (&v)[8], const float (&sc)[8], LAS float* buf, int wave, int lane) {
    const int kr = 16 * wave + (lane >> 5), g = lane & 31;
#pragma unroll
    for (int i = 0; i < 8; ++i) { const int k = kr + 2 * i; *(LAS f32x4*)(buf + k * 128 + 4 * (g ^ (k >> 4))) = v[i] * sc[i]; }
}
__device__ __forceinline__ void blk_emit(const BlkJob& cur, const LAS float* buf, int wave, int lane) {
    const int c = lane & 7;
#pragma unroll
    for (int jj = 0; jj < 2; ++jj) { const int nn = 16 * wave + (lane >> 3) + 8 * jj; const LAS float* sp = buf + (16 * c) * 128 + 4 * ((nn >> 2) ^ c) + (nn & 3);
        u32x4 o;
#pragma unroll
        for (int q = 0; q < 4; ++q) { int w = 0; w = __builtin_amdgcn_cvt_pk_fp8_f32(sp[(4 * q) * 128], sp[(4 * q + 1) * 128], w, false); w = __builtin_amdgcn_cvt_pk_fp8_f32(sp[(4 * q + 2) * 128], sp[(4 * q + 3) * 128], w, true); o[q] = (unsigned)w; }
        __builtin_nontemporal_store(o, (GAS u32x4*)(cur.WQ + (size_t)(cur.nb * 128 + nn) * cur.K + cur.kb * 128 + 16 * c)); }
}
__device__ __forceinline__ void moe_convert_blocks(const float* w1, const float* w2, const float* gffn, unsigned char* ws, int it0, int n, LAS unsigned char* lds, int wave, int lane, const float* wpg, const float* gple, const float* win, const float* gmix, const float* wap, const float* wlp, const float* wout) {
    if (n <= 0) return;
    const int itl = it0 + n - 1;
    BlkJob j0 = moe_blk(w1, w2, gffn, ws, it0, wpg, gple, win, gmix, wap, wlp, wout), j1 = moe_blk(w1, w2, gffn, ws, it0 + 1 < itl ? it0 + 1 : itl, wpg, gple, win, gmix, wap, wlp, wout);
    f32x4 v0[8], v1[8]; float s0[8], s1[8];
    blk_load(j0, v0, s0, wave, lane);
    blk_load(j1, v1, s1, wave, lane);
    LAS float* bufA = (LAS float*)lds; LAS float* bufB = (LAS float*)(lds + 65536);
#pragma unroll 1
    for (int b = 0; b < n; b += 2) {
        blk_put(v0, s0, bufA, wave, lane);
        __syncthreads();
        const BlkJob c0 = j0;
        { const int t = it0 + b + 2; j0 = moe_blk(w1, w2, gffn, ws, t < itl ? t : itl, wpg, gple, win, gmix, wap, wlp, wout); blk_load(j0, v0, s0, wave, lane); }
        blk_emit(c0, bufA, wave, lane);
        blk_put(v1, s1, bufB, wave, lane);
        __syncthreads();
        const BlkJob c1 = j1;
        { const int t = it0 + b + 3; j1 = moe_blk(w1, w2, gffn, ws, t < itl ? t : itl, wpg, gple, win, gmix, wap, wlp, wout); blk_load(j1, v1, s1, wave, lane); }
        blk_emit(c1, bufB, wave, lane);
    }
    __syncthreads();
}

__device__ __forceinline__ void blk_dma(const BlkJob& j, LAS unsigned char* img, int wave, int lane) {
    const g8::Rsrc rs = g8::mk_rsrc(j.W);
    const unsigned voff = (unsigned)(((j.kb * 128 + 16 * wave + (lane >> 5)) * j.N + j.nb * 128 + 4 * ((lane & 31) ^ wave)) * 4);
    const int two_rows = j.N * 8;
#pragma unroll
    for (int i = 0; i < 8; ++i) __builtin_amdgcn_raw_ptr_buffer_load_lds(rs, (LAS void*)(img + (16 * wave + 2 * i) * 512), 16, (int)voff, i * two_rows, 0, 2);
}
__device__ __forceinline__ void blk_emit_s(const BlkJob& cur, const LAS float* buf, const LAS float* scl, int wave, int lane) {
    const int c = lane & 7;
    float sc[16];
#pragma unroll
    for (int q = 0; q < 4; ++q) { const f32x4 t = *(const LAS f32x4*)(scl + ((cur.kb * 128 + 16 * c + 4 * q) & 2047));
#pragma unroll
        for (int e = 0; e < 4; ++e) sc[4 * q + e] = (cur.use_scale ? t[e] : 1.0f) * W8_SCALE; }
#pragma unroll
    for (int jj = 0; jj < 2; ++jj) { const int nn = 16 * wave + (lane >> 3) + 8 * jj; const LAS float* sp = buf + (16 * c) * 128 + 4 * ((nn >> 2) ^ c) + (nn & 3);
        u32x4 o;
#pragma unroll
        for (int q = 0; q < 4; ++q) { int w = 0; w = __builtin_amdgcn_cvt_pk_fp8_f32(sp[(4 * q) * 128] * sc[4 * q], sp[(4 * q + 1) * 128] * sc[4 * q + 1], w, false);
            w = __builtin_amdgcn_cvt_pk_fp8_f32(sp[(4 * q + 2) * 128] * sc[4 * q + 2], sp[(4 * q + 3) * 128] * sc[4 * q + 3], w, true); o[q] = (unsigned)w; }
        __builtin_nontemporal_store(o, (GAS u32x4*)(cur.WQ + (size_t)(cur.nb * 128 + nn) * cur.K + cur.kb * 128 + 16 * c)); }
}
#define DMA_BAR() do { asm volatile("s_waitcnt lgkmcnt(0)" ::: "memory"); __builtin_amdgcn_s_barrier(); asm volatile("" ::: "memory"); } while (0)
__device__ __forceinline__ void moe_convert_blocks_dma(const float* w1, const float* w2, const float* gffn, unsigned char* ws, int it0, int n, LAS unsigned char* lds, int wave, int lane, const float* wpg, const float* gple, const float* win, const float* gmix, const float* wap, const float* wlp, const float* wout, const float* sclg) {
    if (n <= 0) return;
    LAS float* scl = (LAS float*)(lds + 131072);
    { int t = threadIdx.x; asm volatile("" : "+v"(t)); *(LAS f32x4*)(scl + 4 * t) = *(const GAS f32x4*)(sclg + 4 * t); }
    const int itl = it0 + n - 1;
    BlkJob j0 = moe_blk(w1, w2, gffn, ws, it0, wpg, gple, win, gmix, wap, wlp, wout), j1 = moe_blk(w1, w2, gffn, ws, it0 + 1 < itl ? it0 + 1 : itl, wpg, gple, win, gmix, wap, wlp, wout);
    __syncthreads();
    blk_dma(j0, lds, wave, lane);
    blk_dma(j1, lds + 65536, wave, lane);
    asm volatile("s_waitcnt vmcnt(8)" ::: "memory");
#pragma unroll 1
    for (int b = 0; b < n; b += 2) {
        DMA_BAR();
        blk_emit_s(j0, (const LAS float*)lds, scl, wave, lane);
        DMA_BAR();
        { const int t = it0 + b + 2; j0 = moe_blk(w1, w2, gffn, ws, t < itl ? t : itl, wpg, gple, win, gmix, wap, wlp, wout); blk_dma(j0, lds, wave, lane); }
        asm volatile("s_waitcnt vmcnt(10)" ::: "memory");
        DMA_BAR();
        blk_emit_s(j1, (const LAS float*)(lds + 65536), scl, wave, lane);
        DMA_BAR();
        { const int t = it0 + b + 3; j1 = moe_blk(w1, w2, gffn, ws, t < itl ? t : itl, wpg, gple, win, gmix, wap, wlp, wout); blk_dma(j1, lds + 65536, wave, lane); }
        asm volatile("s_waitcnt vmcnt(10)" ::: "memory");
    }
    asm volatile("s_waitcnt vmcnt(0)" ::: "memory");
    __syncthreads();
}

struct Args { const float* in[27]; float* out; unsigned char* ws; int ph_lo, ph_hi; };

__device__ __forceinline__ void p0_prologue(const Args& a, LAS unsigned char* lds, int gw, int NGW, int lane, int wave) {
    unsigned char* ws = a.ws;
    LAS float* scr = (LAS float*)(lds + wave * 16896);
    constexpr int NB64 = PN8_FIRST * 4, I_IN = 32 * NB64, I_SQ = 32 * 32, I_PLE = 4 * 32, I_RG = 8 * 16, dummy_ = 0;
    constexpr int NIT = I_IN + 0 * I_SQ + I_PLE + 2 * I_RG; (void)I_SQ; (void)dummy_;
    for (int it = gw; it < NIT; it += NGW) {
        int r = it;
        if (NB64 > 0 && r < I_IN) { const int nb64 = NB64 > 0 ? NB64 : 1; tr_item(a.in[3], INW, (bf16_t*)(ws + WS_WIN), DM, a.in[2], r / nb64, r % nb64, scr, lane); continue; } r -= I_IN;
        if (r < I_PLE) { tr_item(a.in[24], DM, (bf16_t*)(ws + WS_WPLE), PLE, nullptr, r / 32, r % 32, scr, lane); continue; } r -= I_PLE;
        if (r < I_RG) { const int mtx = r >> 4, q = r & 15; tr_item(a.in[7] + (size_t)mtx * 65536, 256, (bf16_t*)(ws + WS_WRG) + (size_t)mtx * 65536, 256, nullptr, q >> 2, q & 3, scr, lane); continue; } r -= I_RG;
        { const int mtx = r >> 4, q = r & 15; tr_item(a.in[9] + (size_t)mtx * 65536, 256, (bf16_t*)(ws + WS_WRG) + (size_t)(8 + mtx) * 65536, 256, nullptr, q >> 2, q & 3, scr, lane); }
    }
    __syncthreads();
    { const int G = NGW / NWAVES, bxx = gw / NWAVES;
      const int per = (NB_IN8 + G - 1) / G, b0 = bxx * per; int n = per; if (b0 + n > NB_IN8) n = NB_IN8 - b0;
      moe_convert_blocks_dma(a.in[19], a.in[21], a.in[16], ws, NB_ALL + b0, n, lds, wave, lane, a.in[25], a.in[23], a.in[3], a.in[2], a.in[13], a.in[14], a.in[15], a.in[2]); }
    const float* x = a.in[0]; bf16_t* XB = (bf16_t*)(ws + WS_XB); float* rstd1 = (float*)(ws + WS_RSTD1); unsigned char* XQ = ws + WS_H1Q;
    for (int m = gw; m < NTOK; m += NGW) {
        float ss = 0.f;
#pragma unroll
        for (int j = 0; j < 4; ++j) { const size_t o = (size_t)m * DM + j * 512 + lane * 8; const f32x4 v0 = ld4(x + o), v1 = ld4(x + o + 4);
            ss += (v0[0] * v0[0] + v0[1] * v0[1]) + (v0[2] * v0[2] + v0[3] * v0[3]) + (v1[0] * v1[0] + v1[1] * v1[1]) + (v1[2] * v1[2] + v1[3] * v1[3]);
            if (PN8_FIRST > 0) st16(XB + o, pack8(v0, v1));
            st8(XQ + o, pack8_fp8(v0 * X8_SCALE, v1 * X8_SCALE)); }
        ss = wave_sum(ss);
        if (lane == 0) rstd1[m] = 1.0f / sqrtf(ss * (1.0f / DM) + RMS_EPS);
    }
    const float* p = a.in[1]; bf16_t* PB = (bf16_t*)(ws + WS_PB);
    for (int i = gw * 64 + lane; i < NTOK * PLE / 8; i += NGW * 64) { const size_t o = (size_t)i * 8; st16(PB + o, pack8(ld4(p + o), ld4(p + o + 4))); }
    bf16_t* WRH = (bf16_t*)(ws + WS_WR); bf16_t* WRL = WRH + NEXP * DM;
    for (int i = gw * 64 + lane; i < NEXP * DM; i += NGW * 64) { const int e = i >> 11, k = i & 2047; const float v = a.in[17][(size_t)k * NEXP + e] * a.in[16][k];
        const unsigned h = pk2(v, 0.f) & 0xffffu; const float r = v - __uint_as_float(h << 16); WRH[i] = (bf16_t)h; WRL[i] = (bf16_t)(pk2(r, 0.f) & 0xffffu); }
}

constexpr int KS_PITCH = 80, VS_PITCH = 80, VS_OFF = 256 * KS_PITCH * 2;
typedef short v4i16_t __attribute__((ext_vector_type(4)));
__device__ __forceinline__ u32x2 vtr(const LAS bf16_t* p) { return __builtin_bit_cast(u32x2, __builtin_amdgcn_ds_read_tr16_b64_v4i16((LAS v4i16_t*)p)); }
template <bool ODD>
__device__ __forceinline__ void attn_qg(const LAS bf16_t* Ks, const LAS bf16_t* Vt, const bf16x8 q0, const bf16x8 q1, bf16_t* YA, int m_cur, int nbi, int h, float sink2, int fr, int fq, int dmask, int qg) {
    constexpr int WSKIP = ODD ? 0 : 9, WD = ODD ? 1 : 0, WU = ODD ? 9 : 8;
    f32x4 s[10];
    const int kt0 = qg - (ODD ? 1 : 0);
    int koff = fr * KS_PITCH + fq * 8 + kt0 * 16 * KS_PITCH, voff = (kt0 * 16 + 4 * fq + (fr >> 2)) * VS_PITCH + 4 * (fr & 3);
    asm volatile("" : "+v"(koff), "+v"(voff));
#pragma unroll
    for (int w = 0; w < 10; ++w) {
        if (w == WSKIP) { s[w] = (f32x4){0.f, 0.f, 0.f, 0.f}; continue; }
        const bf16x8 k0 = *(const LAS bf16x8*)(Ks + koff + w * 16 * KS_PITCH), k1 = *(const LAS bf16x8*)(Ks + koff + w * 16 * KS_PITCH + 32);
        f32x4 z = (f32x4){0.f, 0.f, 0.f, 0.f};
        z = __builtin_amdgcn_mfma_f32_16x16x32_bf16(k0, q0, z, 0, 0, 0);
        s[w] = __builtin_amdgcn_mfma_f32_16x16x32_bf16(k1, q1, z, 0, 0, 0);
    }
#pragma unroll
    for (int r = 0; r < 4; ++r) { const bool d = (dmask >> r) & 1; s[WD][r] = d ? s[WD][r] : -3.0e38f; s[WU][r] = d ? -3.0e38f : s[WU][r]; }
    if (nbi == 0) {
#pragma unroll
        for (int w = 0; w < 10; ++w)
#pragma unroll
            for (int r = 0; r < 4; ++r) if (w != WSKIP) s[w][r] = ((kt0 + w) * 16 + 4 * fq + r >= 128) ? s[w][r] : -3.0e38f;
    }
    float mx = sink2;
#pragma unroll
    for (int w = 0; w < 10; ++w) if (w != WSKIP) mx = fmaxf(fmaxf(mx, fmaxf(s[w][0], s[w][1])), fmaxf(s[w][2], s[w][3]));
    mx = fmaxf(mx, __shfl_xor(mx, 16)); mx = fmaxf(mx, __shfl_xor(mx, 32));
    float sum = 0.f;
#pragma unroll
    for (int w = 0; w < 10; ++w)
#pragma unroll
        for (int r = 0; r < 4; ++r) if (w != WSKIP) { const float pv = __builtin_amdgcn_exp2f(s[w][r] - mx); s[w][r] = pv; sum += pv; }
    sum += __shfl_xor(sum, 16); sum += __shfl_xor(sum, 32);
    sum += __builtin_amdgcn_exp2f(sink2 - mx);
    const float inv = __builtin_amdgcn_rcpf(sum);
    f32x4 o[4];
#pragma unroll
    for (int dt = 0; dt < 4; ++dt) o[dt] = (f32x4){0.f, 0.f, 0.f, 0.f};
#pragma unroll
    for (int i2 = 0; i2 < 5; ++i2) {
        union { u32x4 u; bf16x8 v; } pf; pf.u = pack8(s[2 * i2], s[2 * i2 + 1]);
#pragma unroll
        for (int dt = 0; dt < 4; ++dt) {
            const LAS bf16_t* vr = Vt + voff + dt * 16 + 32 * i2 * VS_PITCH;
            union { struct { u32x2 lo, hi; } h2; bf16x8 v; } vf; vf.h2.lo = vtr(vr); vf.h2.hi = vtr(vr + 16 * VS_PITCH);
            o[dt] = __builtin_amdgcn_mfma_f32_16x16x32_bf16(vf.v, pf.v, o[dt], 0, 0, 0);
        }
    }
    unsigned char* yo = (unsigned char*)YA + (size_t)(m_cur + qg * 16 + fr) * DM + h * 64 + 4 * fq; const float inv8 = inv * Y8_SCALE;
#pragma unroll
    for (int dt = 0; dt < 4; ++dt) { int w = 0; w = __builtin_amdgcn_cvt_pk_fp8_f32(o[dt][0] * inv8, o[dt][1] * inv8, w, false); w = __builtin_amdgcn_cvt_pk_fp8_f32(o[dt][2] * inv8, o[dt][3] * inv8, w, true); *(GAS unsigned*)(yo + dt * 16) = (unsigned)w; }
}

__device__ __forceinline__ void attn_unit(LAS unsigned char* lds, const bf16_t* Z, const float* sinks, bf16_t* YA, int unit, int tid) {
    const int b = unit >> 7, nbi = (unit >> 2) & 31, kvh = unit & 3;
    const int m_cur = b * SEQ + nbi * 128;
    LAS bf16_t* Ks = (LAS bf16_t*)lds; LAS bf16_t* Vt = (LAS bf16_t*)(lds + VS_OFF);
    const int wid = tid >> 6, lane = tid & 63, fr = lane & 15, fq = lane >> 4;
    const int h = kvh * 8 + wid;
    const bf16_t* qbase = Z + (size_t)(m_cur + fr) * INW + COL_Q + h * 64 + fq * 8;
    bf16x8 qn0 = *(const GAS bf16x8*)(qbase), qn1 = *(const GAS bf16x8*)(qbase + 32), qn2 = *(const GAS bf16x8*)(qbase + 16 * INW), qn3 = *(const GAS bf16x8*)(qbase + 16 * INW + 32);
    u32x4 kv[4], vv[4];
#pragma unroll
    for (int i = 0; i < 4; ++i) {
        const int c = tid + 512 * i, j = c >> 3, c8 = c & 7; const bool valid = (nbi > 0) || (j >= 128);
        const size_t ro = (size_t)(valid ? m_cur - 128 + j : m_cur) * INW;
        kv[i] = ld16(Z + ro + COL_K + kvh * 64 + c8 * 8); vv[i] = ld16(Z + ro + COL_V + kvh * 64 + c8 * 8);
    }
#pragma unroll
    for (int i = 0; i < 4; ++i) {
        const int c = tid + 512 * i, j = c >> 3, c8 = c & 7;
        *(LAS u32x4*)(Ks + j * KS_PITCH + c8 * 8) = kv[i];
        *(LAS u32x4*)(Vt + j * VS_PITCH + c8 * 8) = vv[i];
    }
    __syncthreads();
    const float sink = sinks[h];
    const float sink2 = sink * 1.4426950409f;
    const int dmask = ((4 * fq + 0 > fr) ? 1 : 0) | ((4 * fq + 1 > fr) ? 2 : 0) | ((4 * fq + 2 > fr) ? 4 : 0) | ((4 * fq + 3 > fr) ? 8 : 0);
    __builtin_amdgcn_s_waitcnt(0x0F70);
#pragma unroll 1
    for (int qp = 0; qp < 4; ++qp) {
        const bf16x8 qc0 = qn0, qc1 = qn1, qc2 = qn2, qc3 = qn3;
        const bf16_t* qnx = qbase + (size_t)(qp < 3 ? 32 * (qp + 1) : 96) * INW;
        qn0 = *(const GAS bf16x8*)(qnx); qn1 = *(const GAS bf16x8*)(qnx + 32); qn2 = *(const GAS bf16x8*)(qnx + 16 * INW); qn3 = *(const GAS bf16x8*)(qnx + 16 * INW + 32);
        attn_qg<false>(Ks, Vt, qc0, qc1, YA, m_cur, nbi, h, sink2, fr, fq, dmask, 2 * qp);
        attn_qg<true>(Ks, Vt, qc2, qc3, YA, m_cur, nbi, h, sink2, fr, fq, dmask, 2 * qp + 1);
    }
    __syncthreads();
}

__device__ __forceinline__ void conv_items(const bf16_t* Z, const float* cw, const float* cb, bf16_t* UC, int gw, int NGW, int lane) {
    for (int it = gw; it < 2048; it += NGW) {
        const int cblk = it & 3, tch = it >> 2, c8 = cblk * 512 + lane * 8, m0 = tch * 32;
        f32x4 w0[4], w1[4];
#pragma unroll
        for (int tap = 0; tap < 4; ++tap) { w0[tap] = ld4(cw + tap * DM + c8); w1[tap] = ld4(cw + tap * DM + c8 + 4); }
        const f32x4 b0 = ld4(cb + c8), b1 = ld4(cb + c8 + 4);
        const bf16_t* zp = Z + (size_t)m0 * INW + COL_U + c8;
        u32x4 h[3];
#pragma unroll
        for (int q = 0; q < 3; ++q) h[q] = ((m0 & (SEQ - 1)) == 0) ? (u32x4){0u, 0u, 0u, 0u} : ld16(zp - (size_t)(3 - q) * INW);
#pragma unroll 1
        for (int t0 = 0; t0 < 32; t0 += 8) {
            u32x4 r[8];
#pragma unroll
            for (int j = 0; j < 8; ++j) r[j] = ld16(zp + (size_t)(t0 + j) * INW);
#pragma unroll
            for (int j = 0; j < 8; ++j) {
                f32x4 a0 = b0, a1 = b1, u0, u1;
                unpack8(h[0], u0, u1); a0 += u0 * w0[0]; a1 += u1 * w1[0];
                unpack8(h[1], u0, u1); a0 += u0 * w0[1]; a1 += u1 * w1[1];
                unpack8(h[2], u0, u1); a0 += u0 * w0[2]; a1 += u1 * w1[2];
                unpack8(r[j], u0, u1); a0 += u0 * w0[3]; a1 += u1 * w1[3];
                st16(UC + (size_t)(m0 + t0 + j) * DM + c8, pack8(a0, a1));
                h[0] = h[1]; h[1] = h[2]; h[2] = r[j];
            }
        }
    }
}

constexpr int SC_PITCH = 72;
__device__ __forceinline__ void scan_unit(LAS unsigned char* lds, const bf16_t* LA2, const bf16_t* XIN, const bf16_t* GG, bf16_t* YL, int unit, int tid) {
    const int b = unit >> 6, cg = unit & 63, pair = tid & 15, sub = tid >> 4;
    const size_t base = (size_t)unit * SEQ * 32;
    LAS unsigned char* sA = lds; LAS unsigned char* sX = lds + 256 * SC_PITCH; LAS unsigned char* sG = lds + 2 * 256 * SC_PITCH;
    LAS float* sP = (LAS float*)(lds + 3 * 256 * SC_PITCH); LAS float* sH = sP + 1024; LAS float* sC = sH + 1024;
    if (tid < 32) sC[tid] = 0.f;
    u32x4 ra[2], rx[2], rg[2];
#pragma unroll
    for (int i = 0; i < 2; ++i) { const size_t o = base + (size_t)(tid + 512 * i) * 8; ra[i] = ld16(LA2 + o); rx[i] = ld16(XIN + o); rg[i] = ld16(GG + o); }
#pragma unroll 1
    for (int c = 0; c < 16; ++c) {
#pragma unroll
        for (int i = 0; i < 2; ++i) { const int q = tid + 512 * i, off = (q >> 2) * SC_PITCH + (q & 3) * 16;
            *(LAS u32x2*)(sA + off) = (u32x2){ra[i].x, ra[i].y}; *(LAS u32x2*)(sA + off + 8) = (u32x2){ra[i].z, ra[i].w};
            *(LAS u32x2*)(sX + off) = (u32x2){rx[i].x, rx[i].y}; *(LAS u32x2*)(sX + off + 8) = (u32x2){rx[i].z, rx[i].w};
            *(LAS u32x2*)(sG + off) = (u32x2){rg[i].x, rg[i].y}; *(LAS u32x2*)(sG + off + 8) = (u32x2){rg[i].z, rg[i].w}; }
        __syncthreads();
        if (c < 15) {
#pragma unroll
            for (int i = 0; i < 2; ++i) { const size_t o = base + (size_t)(c + 1) * 8192 + (size_t)(tid + 512 * i) * 8; ra[i] = ld16(LA2 + o); rx[i] = ld16(XIN + o); rg[i] = ld16(GG + o); }
        }
        float a0[8], a1[8], x0[8], x1[8]; float P0 = 1.f, P1 = 1.f, H0 = 0.f, H1 = 0.f;
        const int lo = (sub * 8) * SC_PITCH + pair * 4;
#pragma unroll
        for (int j = 0; j < 8; ++j) { const unsigned la = *(const LAS unsigned*)(sA + lo + j * SC_PITCH), xx = *(const LAS unsigned*)(sX + lo + j * SC_PITCH);
            a0[j] = __builtin_amdgcn_exp2f(bflo(la)); a1[j] = __builtin_amdgcn_exp2f(bfhi(la)); x0[j] = bflo(xx); x1[j] = bfhi(xx);
            H0 = a0[j] * H0 + x0[j]; P0 *= a0[j]; H1 = a1[j] * H1 + x1[j]; P1 *= a1[j]; }
        sP[sub * 32 + 2 * pair] = P0; sP[sub * 32 + 2 * pair + 1] = P1; sH[sub * 32 + 2 * pair] = H0; sH[sub * 32 + 2 * pair + 1] = H1;
        __syncthreads();
        float h0 = sC[2 * pair], h1 = sC[2 * pair + 1];
#pragma unroll 1
        for (int sI = 0; sI < sub; ++sI) { h0 = sP[sI * 32 + 2 * pair] * h0 + sH[sI * 32 + 2 * pair]; h1 = sP[sI * 32 + 2 * pair + 1] * h1 + sH[sI * 32 + 2 * pair + 1]; }
        unsigned char* yo = (unsigned char*)YL + (size_t)(b * SEQ + c * 256 + sub * 8) * DM + cg * 32 + 2 * pair;
#pragma unroll
        for (int j = 0; j < 8; ++j) { h0 = a0[j] * h0 + x0[j]; h1 = a1[j] * h1 + x1[j]; const unsigned g = *(const LAS unsigned*)(sG + lo + j * SC_PITCH);
            const float y0 = __builtin_amdgcn_fmed3f(h0 * bflo(g) * Y8_SCALE, -448.0f, 448.0f), y1 = __builtin_amdgcn_fmed3f(h1 * bfhi(g) * Y8_SCALE, -448.0f, 448.0f);
            *(GAS unsigned short*)(yo + (size_t)j * DM) = (unsigned short)__builtin_amdgcn_cvt_pk_fp8_f32(y0, y1, 0, false); }
        __syncthreads();
        if (sub == 31) { sC[2 * pair] = h0; sC[2 * pair + 1] = h1; }
    }
    __syncthreads();
}

__device__ __forceinline__ void router_unit(LAS unsigned char* lds, const float* H1, const bf16_t* WRH, const bf16_t* WRL, const float* b_r,
                                            float* topw, float* rstd2, int* elist, float* prs, float* pw, unsigned* ecnt, int unit, int tid) {
    const int wid = tid >> 6, lane = tid & 63, rg = wid >> 2, kq = wid & 3;
    LAS float* part = (LAS float*)lds;
    LAS float* ssp = part + 8 * 32 * 33;
    LAS float* lg = ssp + 256;
    LAS int* lcnt = (LAS int*)(lg + 64 * 33);
    LAS int* gbase = lcnt + 32;
    LAS float* lrs = (LAS float*)(gbase + 32);
    const int row0 = unit * 64;
    if (tid < 32) lcnt[tid] = 0;
    const float* xr = H1 + (size_t)(row0 + rg * 32 + (lane & 31)) * DM + kq * 512 + (lane >> 5) * 8;
    const bf16_t* wh = WRH + (size_t)(lane & 31) * DM + kq * 512 + (lane >> 5) * 8; const bf16_t* wl = WRL + (size_t)(lane & 31) * DM + kq * 512 + (lane >> 5) * 8;
    f32x16 acc;
#pragma unroll
    for (int i = 0; i < 16; ++i) acc[i] = 0.f;
    float ss = 0.f;
#pragma unroll 4
    for (int ks = 0; ks < 32; ++ks) {
        const f32x4 x0 = ld4(xr + ks * 16), x1 = ld4(xr + ks * 16 + 4);
        ss += (x0[0] * x0[0] + x0[1] * x0[1]) + (x0[2] * x0[2] + x0[3] * x0[3]) + (x1[0] * x1[0] + x1[1] * x1[1]) + (x1[2] * x1[2] + x1[3] * x1[3]);
        union { u32x4 u; bf16x8 v; } ah, alo, bh, bl;
        ah.u = pack8(x0, x1);
        f32x4 h0, h1; unpack8(ah.u, h0, h1);
        alo.u = pack8(x0 - h0, x1 - h1);
        bh.u = ld16(wh + ks * 16); bl.u = ld16(wl + ks * 16);
        acc = __builtin_amdgcn_mfma_f32_32x32x16_bf16(ah.v, bh.v, acc, 0, 0, 0);
        acc = __builtin_amdgcn_mfma_f32_32x32x16_bf16(alo.v, bh.v, acc, 0, 0, 0);
        acc = __builtin_amdgcn_mfma_f32_32x32x16_bf16(ah.v, bl.v, acc, 0, 0, 0);
    }
    ss += __shfl_xor(ss, 32);
    if (lane < 32) ssp[wid * 32 + lane] = ss;
#pragma unroll
    for (int r = 0; r < 16; ++r) { const int row = (r & 3) + 8 * (r >> 2) + 4 * (lane >> 5); part[(wid * 32 + row) * 33 + (lane & 31)] = acc[r]; }
    __syncthreads();
    {
        const int r = tid >> 3, e0 = (tid & 7) * 4, g = r >> 5, rr = r & 31;
        const float sq = (ssp[(g * 4 + 0) * 32 + rr] + ssp[(g * 4 + 1) * 32 + rr]) + (ssp[(g * 4 + 2) * 32 + rr] + ssp[(g * 4 + 3) * 32 + rr]);
        const float rs = 1.0f / sqrtf(sq * (1.0f / DM) + RMS_EPS);
#pragma unroll
        for (int j = 0; j < 4; ++j) { const int e = e0 + j;
            const float d = (part[((g * 4 + 0) * 32 + rr) * 33 + e] + part[((g * 4 + 1) * 32 + rr) * 33 + e]) + (part[((g * 4 + 2) * 32 + rr) * 33 + e] + part[((g * 4 + 3) * 32 + rr) * 33 + e]);
            lg[r * 33 + e] = d * rs + b_r[e]; }
        if ((tid & 7) == 0) { rstd2[row0 + r] = rs; lrs[r] = rs; }
    }
    __syncthreads();
    int pe[4], pp[4]; float pv[4];
    if (tid < 64) {
        int used = 0;
#pragma unroll
        for (int k = 0; k < 4; ++k) { float best = -3.0e38f; int bi = 0;
            for (int e = 0; e < 32; ++e) { const float v = lg[tid * 33 + e]; const bool free_ = ((used >> e) & 1) == 0; if (free_ && v > best) { best = v; bi = e; } }
            used |= 1 << bi; pe[k] = bi; pv[k] = best; }
        const float m0 = pv[0]; float sum = 0.f;
#pragma unroll
        for (int k = 0; k < 4; ++k) { pv[k] = __expf(pv[k] - m0); sum += pv[k]; }
        const float inv = 1.0f / sum;
#pragma unroll
        for (int k = 0; k < 4; ++k) { pv[k] *= inv; pp[k] = atomicAdd((int*)&lcnt[pe[k]], 1); }
    }
    __syncthreads();
    if (tid < 32) gbase[tid] = (int)__hip_atomic_fetch_add(ecnt + 64 * tid, (unsigned)lcnt[tid], __ATOMIC_RELAXED, __HIP_MEMORY_SCOPE_AGENT);
    __syncthreads();
    if (tid < 64) {
        const int row = row0 + tid;
#pragma unroll
        for (int k = 0; k < 4; ++k) { const size_t ix = (size_t)pe[k] * NTOK + gbase[pe[k]] + pp[k]; elist[ix] = row * 4 + k; prs[ix] = lrs[tid]; pw[ix] = pv[k]; topw[row * 4 + k] = pv[k]; }
    }
    __syncthreads();
}

constexpr int NPH = 13;
#ifndef N_CONV_WG
#define N_CONV_WG 64
#endif
#define FRESH_TID() ({ int _t = threadIdx.x; asm volatile("" : "+v"(_t)); _t; })
#define WSP(T, off) ((T*)(ws + (off)))
__global__ void __launch_bounds__(NTHR, 2) mega(Args a) {
    extern __shared__ __attribute__((aligned(16))) unsigned char lds_raw[];
    LAS unsigned char* lds = (LAS unsigned char*)lds_raw;
    volatile LAS unsigned* MISC = (volatile LAS unsigned*)(lds + MISC_OFF);
    const int G = gridDim.x, bx = blockIdx.x, NGW = G * NWAVES;
    unsigned char* ws = a.ws; unsigned* ctl = (unsigned*)(ws + WS_CTL);
    const int lo = a.ph_lo, hi = a.ph_hi;
    if (threadIdx.x < 4) MISC[threadIdx.x] = 0u;
    __syncthreads();
    XcdBarrier bar; bar.bar = ctl + CW_BAR; bar.x = 0; bar.st = MISC;
    if (hi - lo > 1) bar = xcd_barrier_post(ctl + CW_BAR, MISC);
#ifndef PH_MASK
#define PH_MASK 0xFFFF
#endif
#ifndef REPEAT_MASK
#define REPEAT_MASK 0
#endif
#ifndef MOE2_REP_STUB
#define MOE2_REP_STUB 0
#endif
#define IN(k) (((PH_MASK >> (k)) & 1) && lo <= (k) && (k) < hi)
#define SEAM(k) do { if (IN(k) && IN((k) + 1)) xcd_barrier(bar); } while (0)
#define WAVE_IDS() const int tid = FRESH_TID(); const int lane = tid & 63, wave = __builtin_amdgcn_readfirstlane(tid >> 6), gw = bx * NWAVES + wave; (void)lane; (void)gw

    if (IN(0)) { WAVE_IDS(); p0_prologue(a, lds, gw, NGW, lane, wave); }
#if (REPEAT_MASK >> 0) & 1
    if (IN(0)) { WAVE_IDS(); p0_prologue(a, lds, gw, NGW, lane, wave); }
#endif
    SEAM(0);
    if (IN(1)) {
        WAVE_IDS(); volatile LAS int* mbox = (volatile LAS int*)(lds + MISC_OFF + 512);
        ProbInProj p; p.S.init(64, 42, G, bx); p.A = WSP(bf16_t, WS_XB); p.Bt = WSP(bf16_t, WS_WIN); p.rstd = WSP(float, WS_RSTD1); p.bias = a.in[4]; p.Z = WSP(bf16_t, WS_Z); p.GG = WSP(bf16_t, WS_GG);
        p.D.q = ctl + CW_QG1; p.D.slot = mbox; p.D.x0 = (int)(xb_xcc_id() & 7u); p.D.nper = 8 * PN_GA; p.D.pn0 = 0;
        ProbInProj8 p8; p8.XQ = WSP(unsigned char, WS_H1Q); p8.W8 = WSP(unsigned char, WS_WIN8); p8.rstd = WSP(float, WS_RSTD1); p8.bias = a.in[4]; p8.Z = WSP(bf16_t, WS_Z); p8.GG = WSP(bf16_t, WS_GG);
        p8.D.q = ctl + CW_QG1 + 32; p8.D.slot = mbox; p8.D.x0 = p.D.x0; p8.D.nper = 8 * (42 - PN_GA); p8.D.pn0 = PN_GA;
        const int per_wg = (NB_ALL + G - 1) / G;
#ifndef CONV_GROUPS
#define CONV_GROUPS 2
#endif
#define CONV_ARGS a.in[25], a.in[23], a.in[3], a.in[2], a.in[13], a.in[14], a.in[15]
#define CONV_SLOT(sl) do { if ((bx % CONV_GROUPS) == (sl)) { \
            const int w0 = bx * per_wg; int n = per_wg; if (w0 + n > NB_ALL) n = NB_ALL - w0; const int w1e = w0 + n; \
              \
            const int e1 = w1e < NB_MOE ? w1e : NB_MOE, s2 = w0 > NB_MOE ? w0 : NB_MOE, e2 = w1e < NB_MOE + NB_PG ? w1e : NB_MOE + NB_PG, s3 = w0 > NB_MOE + NB_PG ? w0 : NB_MOE + NB_PG; \
            moe_convert_blocks_dma(a.in[19], a.in[21], a.in[16], ws, w0, e1 - w0, lds, wave, lane, CONV_ARGS, a.in[16]); \
            moe_convert_blocks(a.in[19], a.in[21], a.in[16], ws, s2, e2 - s2, lds, wave, lane, CONV_ARGS); \
            moe_convert_blocks_dma(a.in[19], a.in[21], a.in[16], ws, s3, w1e - s3, lds, wave, lane, CONV_ARGS, a.in[16]); } } while (0)
#if PN8_FIRST > 0
        CONV_SLOT(0); p.D.quota = 4; gemm_phase(lds, p);
        CONV_SLOT(1); p.D.quota = 1 << 20; gemm_phase(lds, p);
        p8.D.quota = 1 << 20; gemm_phase(lds, p8);
#else
        (void)p;
        CONV_SLOT(0); p8.D.quota = P1_Q1; gemm_phase(lds, p8);
        CONV_SLOT(1); p8.D.quota = 1 << 20; gemm_phase(lds, p8);
#endif
#undef CONV_SLOT
#undef CONV_ARGS
    }
    SEAM(1);
    if (IN(2)) {
        WAVE_IDS();
#ifndef NO_ATTN
        for (int u = bx; u < 512; u += G) attn_unit(lds, WSP(bf16_t, WS_Z), a.in[12], WSP(bf16_t, WS_YA), u, tid);
#endif
#ifndef NO_CONV
        conv_items(WSP(bf16_t, WS_Z), a.in[5], a.in[6], WSP(bf16_t, WS_UC), gw, NGW, lane);
#endif
    }
#if (REPEAT_MASK >> 2) & 1
    if (IN(2)) {
        WAVE_IDS();
#ifndef REP_NO_ATTN
        for (int u = bx; u < 512; u += G) attn_unit(lds, WSP(bf16_t, WS_Z), a.in[12], WSP(bf16_t, WS_YA), u, tid);
#endif
#ifndef REP_NO_CONV
        conv_items(WSP(bf16_t, WS_Z), a.in[5], a.in[6], WSP(bf16_t, WS_UC), gw, NGW, lane);
#endif
    }
#endif
    SEAM(2);
    if (IN(3)) { ProbGates p; p.G = G; p.c = bx; p.UC = WSP(bf16_t, WS_UC); p.W = WSP(bf16_t, WS_WRG); p.b_a = a.in[8]; p.b_x = a.in[10]; p.lam = a.in[11]; p.LA2 = WSP(bf16_t, WS_LA2); p.XIN = WSP(bf16_t, WS_XIN); gemm_phase(lds, p); }
#if (REPEAT_MASK >> 3) & 1
    if (IN(3)) { ProbGates p; p.G = G; p.c = bx; p.UC = WSP(bf16_t, WS_UC); p.W = WSP(bf16_t, WS_WRG); p.b_a = a.in[8]; p.b_x = a.in[10]; p.lam = a.in[11]; p.LA2 = WSP(bf16_t, WS_LA2); p.XIN = WSP(bf16_t, WS_XIN); gemm_phase(lds, p); }
#endif
    SEAM(3);
    if (IN(4)) { WAVE_IDS(); for (int u = bx; u < 256; u += G) scan_unit(lds, WSP(bf16_t, WS_LA2), WSP(bf16_t, WS_XIN), WSP(bf16_t, WS_GG), WSP(bf16_t, WS_YL), u, tid); }
#if (REPEAT_MASK >> 4) & 1
    if (IN(4)) { WAVE_IDS(); for (int u = bx; u < 256; u += G) scan_unit(lds, WSP(bf16_t, WS_LA2), WSP(bf16_t, WS_XIN), WSP(bf16_t, WS_GG), WSP(bf16_t, WS_YL), u, tid); }
#endif
    SEAM(4);
    if (IN(5)) { ProbProj2 p; p.S.init(64, 8, G, bx); p.YA = WSP(bf16_t, WS_YA); p.YL = WSP(bf16_t, WS_YL); p.WA = WSP(bf16_t, WS_WAP); p.WL = WSP(bf16_t, WS_WLP); p.Z = WSP(bf16_t, WS_Z); p.MG = WSP(bf16_t, WS_MG); gemm_phase(lds, p); }
#if (REPEAT_MASK >> 5) & 1
    if (IN(5)) { ProbProj2 p; p.S.init(64, 8, G, bx); p.YA = WSP(bf16_t, WS_YA); p.YL = WSP(bf16_t, WS_YL); p.WA = WSP(bf16_t, WS_WAP); p.WL = WSP(bf16_t, WS_WLP); p.Z = WSP(bf16_t, WS_Z); p.MG = WSP(bf16_t, WS_MG); gemm_phase(lds, p); }
#endif
    SEAM(5);
    if (IN(6)) { ProbOut p; p.S.init(64, 8, G, bx); p.A = WSP(bf16_t, WS_MG); p.Bt = WSP(bf16_t, WS_WOUT); p.X = a.in[0]; p.H1 = WSP(float, WS_H1); p.H1Q = WSP(unsigned char, WS_H1Q); gemm_phase(lds, p); }
#if (REPEAT_MASK >> 6) & 1
    if (IN(6)) { ProbOut p; p.S.init(64, 8, G, bx); p.A = WSP(bf16_t, WS_MG); p.Bt = WSP(bf16_t, WS_WOUT); p.X = a.in[0]; p.H1 = WSP(float, WS_H1); p.H1Q = WSP(unsigned char, WS_H1Q); gemm_phase(lds, p); }
#endif
    SEAM(6);
    if (IN(7)) { WAVE_IDS(); for (int u = bx; u < 256; u += G) router_unit(lds, WSP(float, WS_H1), WSP(bf16_t, WS_WR), WSP(bf16_t, WS_WR) + NEXP * DM, a.in[18], WSP(float, WS_TOPW), WSP(float, WS_RSTD2), WSP(int, WS_ELIST), WSP(float, WS_PRS), WSP(float, WS_PW), ctl + CW_ECNT, u, tid); }
#if (REPEAT_MASK >> 7) & 1
    if (IN(7)) { WAVE_IDS(); for (int u = bx; u < 256; u += G) router_unit(lds, WSP(float, WS_H1), WSP(bf16_t, WS_WR), WSP(bf16_t, WS_WR) + NEXP * DM, a.in[18], WSP(float, WS_TOPW), WSP(float, WS_RSTD2), WSP(int, WS_ELIST), WSP(float, WS_PRS), WSP(float, WS_PW), ctl + CW_ECNT, u, tid); }
#endif
    SEAM(7);
    volatile LAS int* tab = (volatile LAS int*)(lds + MISC_OFF + 64);
    if (IN(8) || IN(9)) {
        if (threadIdx.x == 0) { int tp = 0, bp = 0;
            for (int e = 0; e < 32; ++e) { int cn = (int)__hip_atomic_load(ctl + CW_ECNT + 64 * e, __ATOMIC_RELAXED, __HIP_MEMORY_SCOPE_AGENT); cn = cn < 0 ? 0 : (cn > NTOK ? NTOK : cn); tab[e] = tp; tab[33 + e] = bp; tp += (cn + 255) >> 8; bp += cn; }
            tab[32] = tp; tab[65] = bp; }
        __syncthreads();
        if (threadIdx.x < 288) { const int g = threadIdx.x; int e = 0; for (int j = 0; j < 32; ++j) e += (g >= tab[j + 1]) ? 1 : 0; ((volatile LAS unsigned char*)(lds + MISC_OFF + 640))[g] = (unsigned char)(e > 31 ? 31 : e); }
        __syncthreads();
    }
    if (IN(8)) { ProbMoe1 p; p.G = G; p.c = bx; p.tab = tab; p.H1Q = WSP(unsigned char, WS_H1Q); p.W1 = WSP(unsigned char, WS_W1); p.elist = WSP(int, WS_ELIST); p.rstd2 = WSP(float, WS_RSTD2); p.prs = WSP(float, WS_PRS); p.b1 = a.in[20]; p.ACT = WSP(unsigned char, WS_ACT); gemm_phase(lds, p); }
#if (REPEAT_MASK >> 8) & 1
    if (IN(8)) { ProbMoe1 p; p.G = G; p.c = bx; p.tab = tab; p.H1Q = WSP(unsigned char, WS_H1Q); p.W1 = WSP(unsigned char, WS_W1); p.elist = WSP(int, WS_ELIST); p.rstd2 = WSP(float, WS_RSTD2); p.prs = WSP(float, WS_PRS); p.b1 = a.in[20]; p.ACT = WSP(unsigned char, WS_ACT); gemm_phase(lds, p); }
#endif
    SEAM(8);
    if (IN(9)) { ProbMoe2 p; p.G = G; p.c = bx; p.tab = tab; p.ACT = WSP(unsigned char, WS_ACT); p.W2 = WSP(unsigned char, WS_W2); p.elist = WSP(int, WS_ELIST); p.topw = WSP(float, WS_TOPW); p.pw = WSP(float, WS_PW); p.b2 = a.in[22]; p.YB = WSP(unsigned char, WS_YB); gemm_phase(lds, p); }
#if (REPEAT_MASK >> 9) & 1
    if (IN(9)) { ProbMoe2T<MOE2_REP_STUB> p; p.G = G; p.c = bx; p.tab = tab; p.ACT = WSP(unsigned char, WS_ACT); p.W2 = WSP(unsigned char, WS_W2); p.elist = WSP(int, WS_ELIST); p.topw = WSP(float, WS_TOPW); p.pw = WSP(float, WS_PW); p.b2 = a.in[22]; p.YB = WSP(unsigned char, WS_YB); gemm_phase(lds, p); }
#endif
    SEAM(9);
    if (IN(10)) {
        WAVE_IDS(); float* H1 = WSP(float, WS_H1); bf16_t* H1B = WSP(bf16_t, WS_H1B); const unsigned char* YB = WSP(unsigned char, WS_YB); float* RSTD3 = WSP(float, WS_RSTD3); unsigned char* H2Q = WSP(unsigned char, WS_H1Q);
        for (int m = gw; m < NTOK; m += NGW) {
            float ss = 0.f;
#pragma unroll
            for (int j = 0; j < 4; ++j) {
                const size_t o = (size_t)m * DM + j * 512 + lane * 8; f32x4 v0 = ld4(H1 + o), v1 = ld4(H1 + o + 4);
                f32x4 s0 = {0.f, 0.f, 0.f, 0.f}, s1 = s0;
#pragma unroll
                for (int k = 0; k < 4; ++k) { f32x4 y0, y1; unpack8_fp8(*(const GAS u32x2*)(YB + ((size_t)m * 4 + k) * DM + j * 512 + lane * 8), y0, y1); s0 += y0; s1 += y1; }
                v0 += s0 * (1.0f / YB8_SCALE); v1 += s1 * (1.0f / YB8_SCALE);
                ss += (v0[0] * v0[0] + v0[1] * v0[1]) + (v0[2] * v0[2] + v0[3] * v0[3]) + (v1[0] * v1[0] + v1[1] * v1[1]) + (v1[2] * v1[2] + v1[3] * v1[3]);
                st16(H1B + o, pack8(v0, v1));
                st8(H2Q + o, pack8_fp8(v0, v1));
            }
            ss = wave_sum(ss);
            if (lane == 0) RSTD3[m] = 1.0f / sqrtf(ss * (1.0f / DM) + RMS_EPS);
        }
    }
    SEAM(10);
    if (IN(11)) {
        { ProbPle p; p.S.init(64, 8, G, bx); p.A = WSP(bf16_t, WS_PB); p.Bt = WSP(bf16_t, WS_WPLE); p.PE = WSP(bf16_t, WS_PE); gemm_phase(lds, p); }
        { ProbGate8 p; p.S.init(64, 8, G, bx); p.H2Q = WSP(unsigned char, WS_H1Q); p.WPG8 = WSP(unsigned char, WS_WPG); p.H2B = WSP(bf16_t, WS_H1B); p.PE = WSP(bf16_t, WS_PE);
          p.rstd3 = WSP(float, WS_RSTD3); p.H3B = WSP(bf16_t, WS_M1); p.SS3 = WSP(float, WS_SS3); gemm_phase(lds, p); }
    }
    SEAM(11);
    if (IN(12)) {
        WAVE_IDS(); const float* gf = a.in[26]; const float* SS3 = WSP(float, WS_SS3); const bf16_t* H3B = WSP(bf16_t, WS_M1);
        for (int m = gw; m < NTOK; m += NGW) {
            float ss = (lane < 32) ? SS3[(size_t)m * 32 + lane] : 0.f; ss = wave_sum(ss);
            const float rs = 1.0f / sqrtf(ss * (1.0f / DM) + RMS_EPS);
#pragma unroll
            for (int j = 0; j < 4; ++j) { const size_t o = (size_t)m * DM + j * 512 + lane * 8; const int c = j * 512 + lane * 8;
                f32x4 h0, h1; unpack8(ld16(H3B + o), h0, h1);
                st4(a.out + o, h0 * rs * ld4(gf + c)); st4(a.out + o + 4, h1 * rs * ld4(gf + c + 4)); }
        }
    }
#ifdef DBG_STOP
    if (lo == 13) {
        WAVE_IDS(); const float* H1 = WSP(float, WS_H1); (void)H1;
#ifdef DBG_BUF
        const bf16_t* src = (const bf16_t*)(ws + DBG_BUF);
        for (int m = gw; m < NTOK; m += NGW) {
#pragma unroll
            for (int j = 0; j < 4; ++j) { const size_t o = (size_t)m * DM + j * 512 + lane * 8; f32x4 b0, b1; unpack8(ld16(src + (size_t)m * DBG_LD + DBG_COFF + j * 512 + lane * 8), b0, b1);
                for (int q = 0; q < 4; ++q) { if (!(fabsf(b0[q]) < 1e30f)) b0[q] = 1000.f; if (!(fabsf(b1[q]) < 1e30f)) b1[q] = 1000.f; }
                st4(a.out + o, ld4(a.in[0] + o) + b0); st4(a.out + o + 4, ld4(a.in[0] + o + 4) + b1); }
        }
#else
        const float* gf = a.in[26];
        for (int m = gw; m < NTOK; m += NGW) {
            float ss = 0.f; f32x4 v[8];
#pragma unroll
            for (int j = 0; j < 4; ++j) { const size_t o = (size_t)m * DM + j * 512 + lane * 8; v[2 * j] = ld4(H1 + o); v[2 * j + 1] = ld4(H1 + o + 4);
                for (int q = 0; q < 4; ++q) ss += v[2 * j][q] * v[2 * j][q] + v[2 * j + 1][q] * v[2 * j + 1][q]; }
            ss = wave_sum(ss);
            const float rs = 1.0f / sqrtf(ss * (1.0f / DM) + RMS_EPS);
#pragma unroll
            for (int j = 0; j < 4; ++j) { const size_t o = (size_t)m * DM + j * 512 + lane * 8; const int c = j * 512 + lane * 8;
                st4(a.out + o, v[2 * j] * rs * ld4(gf + c)); st4(a.out + o + 4, v[2 * j + 1] * rs * ld4(gf + c + 4)); }
        }
#endif
    }
#endif
#undef IN
#undef SEAM
}

extern "C" void kernel_launch(void* const* d_in, const int* in_sizes, int n_in, void* d_out, int out_size, void* d_ws, size_t ws_size, hipStream_t stream) {
    static int grid = 0;
    if (grid == 0) {
        if (n_in != 27 || out_size != NTOK * DM || ws_size < WS_END) { fprintf(stderr, "kernel_launch: unexpected shapes (n_in %d out %d ws %zu need %zu)\n", n_in, out_size, ws_size, (size_t)WS_END); grid = -1; return; }
        int dev = 0, cus = 0, per_cu = 0;
        if (hipGetDevice(&dev) != hipSuccess || hipDeviceGetAttribute(&cus, hipDeviceAttributeMultiprocessorCount, dev) != hipSuccess) { grid = -1; return; }
        if (hipFuncSetAttribute((const void*)mega, hipFuncAttributeMaxDynamicSharedMemorySize, LDS_BYTES) != hipSuccess) { fprintf(stderr, "kernel_launch: hipFuncSetAttribute failed\n"); grid = -1; return; }
        if (hipOccupancyMaxActiveBlocksPerMultiprocessor(&per_cu, (const void*)mega, NTHR, LDS_BYTES) != hipSuccess || per_cu < 1) fprintf(stderr, "kernel_launch: occupancy query says %d\n", per_cu);
        (void)hipGetLastError();
        grid = cus;
    }
    if (grid < 0) return;
    (void)hipMemsetAsync((char*)d_ws + WS_CTL, 0, CTL_BYTES, stream);
    Args a{};
    for (int i = 0; i < 27; ++i) a.in[i] = (const float*)d_in[i];
    a.out = (float*)d_out; a.ws = (unsigned char*)d_ws;
#if MK_SINGLE
    a.ph_lo = 0; a.ph_hi = NPH;
    hipLaunchKernelGGL(mega, dim3(grid), dim3(NTHR), LDS_BYTES, stream, a);
#else
#ifdef DBG_STOP
    for (int ph = 0; ph <= DBG_STOP; ++ph) { a.ph_lo = ph; a.ph_hi = ph + 1; hipLaunchKernelGGL(mega, dim3(grid), dim3(NTHR), LDS_BYTES, stream, a); }
    a.ph_lo = 13; a.ph_hi = 14; hipLaunchKernelGGL(mega, dim3(grid), dim3(NTHR), LDS_BYTES, stream, a);
#else
    for (int ph = 0; ph < NPH; ++ph) { a.ph_lo = ph; a.ph_hi = ph + 1; hipLaunchKernelGGL(mega, dim3(grid), dim3(NTHR), LDS_BYTES, stream, a); }
#endif
#endif
}
```
